# Optimizing an MI355X kernel written in HIP

```python
import jax, jax.numpy as jnp
from jax import lax
import numpy as np

D_MODEL = 1024
BATCH = 2
SEQ = 8192
DEPTH = 2

BRANCH_WIDTH = D_MODEL // 4
N_BRANCHES = 3
SB_HEADS = 4
SB_HEAD_DIM = BRANCH_WIDTH // SB_HEADS
SB_BLOCK = 128
HGRN_HEADS = 4
HGRN_HEAD_DIM = BRANCH_WIDTH // HGRN_HEADS
HGRN_EXP_CLIP = 60.0
GLA_HEADS = 4
GLA_VALUE_DIM = BRANCH_WIDTH // GLA_HEADS
GLA_KEY_DIM = GLA_VALUE_DIM // 2
GLA_KEY_WIDTH = GLA_HEADS * GLA_KEY_DIM
GLA_GATE_RANK = 16
GLA_TAU = 16.0
CHUNK = 64
NORM_EPS = 1e-5
DEEPNORM_ALPHA = (2 * DEPTH) ** 0.25
DEEPNORM_BETA = (8 * DEPTH) ** -0.25

IN_WIDTHS = (
    BRANCH_WIDTH, BRANCH_WIDTH, BRANCH_WIDTH, BRANCH_WIDTH,
    BRANCH_WIDTH, BRANCH_WIDTH, BRANCH_WIDTH, BRANCH_WIDTH,
    GLA_KEY_WIDTH, GLA_KEY_WIDTH, BRANCH_WIDTH, BRANCH_WIDTH,
    GLA_GATE_RANK,
    D_MODEL, D_MODEL, D_MODEL,
)
IN_SPLITS = tuple(int(s) for s in np.cumsum(IN_WIDTHS)[:-1])
IN_TOTAL = int(sum(IN_WIDTHS))

kernel_name = "hybrid_stickbreak_hgrn2_gla_deepnorm"


def split_heads(a, n_heads):
    b, t, w = a.shape
    return a.reshape(b, t, n_heads, w // n_heads).transpose(0, 2, 1, 3)


def merge_heads(a):
    b, h, t, d = a.shape
    return a.transpose(0, 2, 1, 3).reshape(b, t, h * d)


def masked_exp(mask, log_val):
    return jnp.where(mask, jnp.exp(jnp.where(mask, log_val, 0.0)), 0.0)


def head_rmsnorm(o, gain):
    o = o * lax.rsqrt(jnp.mean(o * o, axis=-1, keepdims=True) + NORM_EPS)
    return merge_heads(o) * gain.astype(jnp.float32)


def layer_norm(x, g, b):
    xf = x.astype(jnp.float32)
    mu = jnp.mean(xf, axis=-1, keepdims=True)
    var = jnp.mean(jnp.square(xf - mu), axis=-1, keepdims=True)
    y = (xf - mu) * lax.rsqrt(var + NORM_EPS) * g.astype(jnp.float32) + b.astype(jnp.float32)
    return y.astype(x.dtype)


def stick_breaking_attention(q, k, v):
    t_len, d = q.shape[2], q.shape[3]
    scale = d ** -0.5
    outs = []
    for blk in range(t_len // SB_BLOCK):
        t0 = blk * SB_BLOCK
        t1 = t0 + SB_BLOCK
        qb, kb, vb = q[:, :, t0:t1], k[:, :, :t1], v[:, :, :t1]
        z = jnp.einsum('bhtd,bhsd->bhts', qb, kb).astype(jnp.float32) * scale
        t_idx = t0 + jnp.arange(SB_BLOCK)[:, None]
        s_idx = jnp.arange(t1)[None, :]
        causal = s_idx < t_idx
        log_beta = jax.nn.log_sigmoid(z)
        log_one_minus = jnp.where(causal, jax.nn.log_sigmoid(-z), 0.0)
        tail = lax.cumsum(log_one_minus, axis=3, reverse=True) - log_one_minus
        weights = masked_exp(causal, log_beta + tail)
        outs.append(jnp.einsum('bhts,bhsd->bhtd', weights, vb.astype(jnp.float32)))
    return jnp.concatenate(outs, axis=2)


def chunked_gated_linear_recurrence(q, k, v, log_f):
    b, h, t_len, dk = q.shape
    dv = v.shape[-1]
    n_chunks = t_len // CHUNK

    def to_chunks(a):
        a = a.astype(jnp.float32)
        return a.reshape(b, h, n_chunks, CHUNK, a.shape[-1]).transpose(2, 0, 1, 3, 4)

    qc, kc, vc, gc = to_chunks(q), to_chunks(k), to_chunks(v), to_chunks(log_f)
    causal = jnp.tril(jnp.ones((CHUNK, CHUNK), dtype=bool))[:, :, None]

    def step(state, inp):
        qi, ki, vi, gi = inp
        cum = jnp.cumsum(gi, axis=2)
        o_inter = jnp.einsum('bhck,bhkv->bhcv', qi * jnp.exp(cum), state)
        diff = cum[:, :, :, None, :] - cum[:, :, None, :, :]
        decay = masked_exp(causal, diff)
        scores = jnp.einsum('bhtsk,bhsk->bhts', qi[:, :, :, None, :] * decay, ki)
        o = o_inter + jnp.einsum('bhts,bhsv->bhtv', scores, vi)
        last = cum[:, :, -1:, :]
        state = jnp.exp(last[:, :, 0, :])[..., None] * state + jnp.einsum(
            'bhsk,bhsv->bhkv', ki * jnp.exp(last - cum), vi)
        return state, o

    state0 = jnp.zeros((b, h, dk, dv), jnp.float32)
    _, o = lax.scan(step, state0, (qc, kc, vc, gc))
    return o.transpose(1, 2, 0, 3, 4).reshape(b, h, t_len, dv)


def hybrid_layer(x, w_in, gla_gate_w2, gla_gate_b, hgrn_lb, hgrn_norm_g, gla_norm_g,
                 w_up, w_out, ln_g, ln_b):
    proj = jnp.einsum('btd,dc->btc', x, w_in)
    (a_q, a_k, a_v, a_g,
     h_f, h_i, h_q, h_g,
     c_q, c_k, c_v, c_g, c_r,
     gate_logits_a, gate_logits_b, gate_logits_c) = jnp.split(proj, IN_SPLITS, axis=-1)

    a_out = stick_breaking_attention(split_heads(a_q, SB_HEADS), split_heads(a_k, SB_HEADS),
                                     split_heads(a_v, SB_HEADS))
    y_a = merge_heads(a_out) * jax.nn.silu(a_g.astype(jnp.float32))

    lb = hgrn_lb.astype(jnp.float32).reshape(HGRN_HEADS, 1, HGRN_HEAD_DIM)
    zf = split_heads(h_f, HGRN_HEADS).astype(jnp.float32)
    log_f = jax.nn.log_sigmoid(zf) + jnp.log1p(lb * jnp.exp(jnp.minimum(-zf, HGRN_EXP_CLIP)))
    h_key = (1.0 - lb) * jax.nn.sigmoid(-zf)
    h_out = chunked_gated_linear_recurrence(split_heads(h_q, HGRN_HEADS), h_key,
                                            split_heads(h_i, HGRN_HEADS), log_f)
    y_b = head_rmsnorm(h_out, hgrn_norm_g) * jax.nn.silu(h_g.astype(jnp.float32))

    gate_pre = jnp.einsum('btr,rk->btk', c_r, gla_gate_w2) + gla_gate_b
    c_log_f = jax.nn.log_sigmoid(gate_pre.astype(jnp.float32)) / GLA_TAU
    c_out = chunked_gated_linear_recurrence(
        split_heads(c_q, GLA_HEADS).astype(jnp.float32) * (GLA_KEY_DIM ** -0.5),
        split_heads(c_k, GLA_HEADS), split_heads(c_v, GLA_HEADS),
        split_heads(c_log_f, GLA_HEADS))
    y_c = head_rmsnorm(c_out, gla_norm_g) * jax.nn.silu(c_g.astype(jnp.float32))

    branches = jnp.stack([y_a, y_b, y_c], axis=0).astype(x.dtype)
    up = jnp.einsum('nbtw,nwd->nbtd', branches, w_up)
    gates = jax.nn.sigmoid(jnp.stack([gate_logits_a, gate_logits_b, gate_logits_c], axis=0))
    merged = jnp.sum(gates * up, axis=0)
    out = jnp.einsum('btd,de->bte', merged, w_out)

    return layer_norm(DEEPNORM_ALPHA * x + out, ln_g, ln_b)


def setup_inputs(seed: int = 0) -> dict:
    key = jax.random.key(seed)
    ks = jax.random.split(key, 11)
    f32 = jnp.float32
    x = jax.random.normal(ks[0], (BATCH, SEQ, D_MODEL), f32)
    w_in = jax.random.normal(ks[1], (DEPTH, D_MODEL, IN_TOTAL), f32) * D_MODEL ** -0.5
    gla_gate_w2 = jax.random.normal(ks[2], (DEPTH, GLA_GATE_RANK, GLA_KEY_WIDTH), f32) * GLA_GATE_RANK ** -0.5
    gla_gate_b = 0.1 * jax.random.normal(ks[3], (DEPTH, GLA_KEY_WIDTH), f32)
    hgrn_lb_logits = 0.5 * jax.random.normal(ks[4], (DEPTH, BRANCH_WIDTH), f32)
    hgrn_norm_g = 1.0 + 0.02 * jax.random.normal(ks[5], (DEPTH, BRANCH_WIDTH), f32)
    gla_norm_g = 1.0 + 0.02 * jax.random.normal(ks[6], (DEPTH, BRANCH_WIDTH), f32)
    w_up = jax.random.normal(ks[7], (DEPTH, N_BRANCHES, BRANCH_WIDTH, D_MODEL), f32) * (
        BRANCH_WIDTH ** -0.5 * DEEPNORM_BETA)
    w_out = jax.random.normal(ks[8], (DEPTH, D_MODEL, D_MODEL), f32) * (D_MODEL ** -0.5 * DEEPNORM_BETA)
    ln_g = 1.0 + 0.02 * jax.random.normal(ks[9], (DEPTH, D_MODEL), f32)
    ln_b = 0.02 * jax.random.normal(ks[10], (DEPTH, D_MODEL), f32)
    return {"x": x, "w_in": w_in, "gla_gate_w2": gla_gate_w2, "gla_gate_b": gla_gate_b,
            "hgrn_lb_logits": hgrn_lb_logits, "hgrn_norm_g": hgrn_norm_g, "gla_norm_g": gla_norm_g,
            "w_up": w_up, "w_out": w_out, "ln_g": ln_g, "ln_b": ln_b}


def reference(x, w_in, gla_gate_w2, gla_gate_b, hgrn_lb_logits, hgrn_norm_g, gla_norm_g,
              w_up, w_out, ln_g, ln_b):
    lb_soft = jax.nn.softmax(hgrn_lb_logits.astype(jnp.float32), axis=0)
    lower_bounds = jnp.cumsum(lb_soft, axis=0) - lb_soft[0:1]
    for layer in range(DEPTH):
        x = hybrid_layer(x, w_in[layer], gla_gate_w2[layer], gla_gate_b[layer],
                         lower_bounds[layer], hgrn_norm_g[layer], gla_norm_g[layer],
                         w_up[layer], w_out[layer], ln_g[layer], ln_b[layer])
    return x
```

```cpp
#include <hip/hip_runtime.h>
#include <hip/hip_cooperative_groups.h>
#include <cstdio>
#include <cstdint>
namespace cg = cooperative_groups;

typedef unsigned short bf16_t;
typedef short bf16x8 __attribute__((ext_vector_type(8)));
typedef float f32x4 __attribute__((ext_vector_type(4)));
typedef float f32x16 __attribute__((ext_vector_type(16)));
typedef unsigned u32x2 __attribute__((ext_vector_type(2)));
typedef unsigned u32x4 __attribute__((ext_vector_type(4)));

constexpr int T_ = 8192, M_ = 16384, D_ = 1024;
constexpr int NIN = 5904;
constexpr int NS1 = 2832;
constexpr int NP = 2560;
constexpr int NWG = 2944;
constexpr int NWT = NWG + 3072;
constexpr int NTH = 512;
constexpr int C_AQ = 0, C_AK = 256, C_AG = 512, C_HF = 768, C_HI = 1024, C_HQ = 1280, C_HG = 1536;
constexpr int C_CQ = 1792, C_CK = 1920, C_CV = 2048, C_CG = 2304, R_AV = 2560, C_CR = 2816;
constexpr float ALPHA = 1.41421356237309515f;
constexpr float EPS = 1e-5f;
constexpr float LOG2E = 1.44269504088896341f, LN2 = 0.69314718055994531f;

constexpr size_t SZ_WT_IN = (size_t)NWT * 1024 * 2, SZ_WT_UP = (size_t)3 * 1024 * 256 * 2, SZ_WT_OUT = (size_t)1024 * 1024 * 2;
constexpr size_t OFF_WT_IN = 0;
constexpr size_t OFF_WT_UP = OFF_WT_IN + 2 * SZ_WT_IN;
constexpr size_t OFF_WT_OUT = OFF_WT_UP + 2 * SZ_WT_UP;
constexpr size_t OFF_XB = OFF_WT_OUT + 2 * SZ_WT_OUT;
constexpr size_t OFF_PROJ = OFF_XB + (size_t)M_ * 1024 * 2;
constexpr size_t OFF_VT = OFF_PROJ + (size_t)M_ * 2816 * 2;
constexpr size_t OFF_GATES = OFF_PROJ;
constexpr size_t OFF_Y = OFF_VT + (size_t)8 * 64 * T_ * 2;
constexpr size_t OFF_SLOC_H = OFF_Y + (size_t)M_ * 768 * 2;
constexpr size_t OFF_SLOC_G = OFF_SLOC_H + (size_t)8 * 128 * 64 * 64 * 4;
constexpr size_t OFF_DEC_H = OFF_SLOC_G + (size_t)8 * 128 * 64 * 32 * 4;
constexpr size_t OFF_DEC_G = OFF_DEC_H + (size_t)8 * 128 * 64 * 4;
constexpr size_t OFF_SST_H = OFF_DEC_G + (size_t)8 * 128 * 32 * 4;
constexpr size_t OFF_SST_G = OFF_SST_H + (size_t)8 * 128 * 64 * 64 * 2;
constexpr size_t OFF_CR = OFF_SST_G + (size_t)8 * 128 * 64 * 32 * 2;
constexpr size_t OFF_BAR = OFF_CR + (size_t)M_ * 16 * 4;
constexpr size_t OFF_STATS = OFF_BAR + 16384;
constexpr size_t OFF_OI = OFF_STATS + (size_t)2 * 64 * 4 * 256 * 8;
constexpr size_t OFF_QH = OFF_OI + (size_t)M_ * 512 * 2;
constexpr size_t WS_NEED = OFF_QH + (size_t)M_ * 384 * 2;
constexpr size_t OFF_MERGED = OFF_SLOC_H;
static_assert(OFF_MERGED + (size_t)M_ * 1024 * 2 <= OFF_CR, "merged overlay");
static_assert(OFF_GATES + (size_t)M_ * 3072 * 2 <= OFF_Y, "gates overlay");

struct Params {
    const float* x; const float* w_in; const float* w2; const float* gb; const float* lbl; const float* hg; const float* gg;
    const float* w_up; const float* w_out; const float* ln_g; const float* ln_b;
    float* out; char* ws;
};

__device__ __forceinline__ float bf2f(bf16_t v) { return __uint_as_float(((unsigned)v) << 16); }
__device__ __forceinline__ float bflo(unsigned v) { return __uint_as_float(v << 16); }
__device__ __forceinline__ float bfhi(unsigned v) { return __uint_as_float(v & 0xffff0000u); }
typedef float f32x2 __attribute__((ext_vector_type(2)));
typedef __bf16 bf16x2v __attribute__((ext_vector_type(2)));
__device__ __forceinline__ unsigned pk_bf16(float lo, float hi) { f32x2 v = {lo, hi}; bf16x2v b = __builtin_convertvector(v, bf16x2v); return __builtin_bit_cast(unsigned, b); }
__device__ __forceinline__ bf16_t f2bf(float f) { return (bf16_t)(pk_bf16(f, 0.f) & 0xffffu); }
__device__ __forceinline__ float ex2(float x) { return __builtin_amdgcn_exp2f(x); }
__device__ __forceinline__ float lg2(float x) { return __builtin_amdgcn_logf(x); }
__device__ __forceinline__ float exn(float x) { return ex2(x * LOG2E); }
__device__ __forceinline__ float lgn(float x) { return lg2(x) * LN2; }
__device__ __forceinline__ float sigmoidf(float x) { return __builtin_amdgcn_rcpf(1.f + exn(-x)); }
__device__ __forceinline__ float siluf(float x) { return x * sigmoidf(x); }
__device__ __forceinline__ float logsigmoidf(float x) { return fminf(x, 0.f) - lgn(1.f + exn(-fabsf(x))); }

__device__ __forceinline__ int otid() { int t = threadIdx.x; asm volatile("" : "+v"(t)); return t; }
__device__ __forceinline__ int obid() { int t = blockIdx.x; asm volatile("" : "+s"(t)); return t; }
__device__ __forceinline__ int onb() { int t = gridDim.x; asm volatile("" : "+s"(t)); return t; }
constexpr int LROW = 72;
constexpr int SMEM_BYTES = 131072;
constexpr int REC_LDS = 55296;
#define LDSP __attribute__((address_space(3)))

__device__ __forceinline__ bool tile_order(int v, int nM, int nN, int& tm, int& tn) {
    const int nwg = nM * nN; if (v >= nwg) return false;
    const int q = nwg / 8, r = nwg % 8, xcd = v % 8, off = v / 8;
    const int wgid = (xcd < r ? xcd * (q + 1) : r * (q + 1) + (xcd - r) * q) + off;
    const int nig = 8 * nN, gid = wgid / nig, fm = gid * 8, gsz = (nM - fm) < 8 ? (nM - fm) : 8;
    tm = fm + ((wgid % nig) % gsz); tn = (wgid % nig) / gsz; return true;
}

__device__ __forceinline__ void stage_rc(int b, int& R, int& C) {
    const int st = b >> 10, sb = b & 1023, swz = sb ^ (((sb >> 9) & 1) << 5);
    R = st * 16 + swz / 64; C = (swz % 64) / 2;
}
template <int MT, int NT>
struct Gemm2P {
    static constexpr int TA = 32 * MT * 64, TB = 64 * NT * 64, GA = TA / 8192, GB = TB / 8192, STG = TA + TB, PAIR = 2 * STG;
    static_assert(2 * PAIR <= SMEM_BYTES && GA >= 1 && GB >= 1, "LDS");
    LDSP char* lds; int wid, aoff, boff, gp;
    unsigned offA[GA], offB[GB]; const char* Ab; const char* Bb; int rowsel;
    __device__ __forceinline__ void init(char* smem) {
        lds = (LDSP char*)smem; gp = 0;
        const int tid = otid(), lane = tid & 63, fr = lane & 15, fq = lane >> 4;
        wid = __builtin_amdgcn_readfirstlane(tid >> 6);
        const int wr = wid >> 2, wc = wid & 3;
        const int lo = ((fr * 64 + fq * 16) ^ ((fr >> 3) << 5));
        aoff = (wr * MT) * 1024 + lo; boff = TA + (wc * NT) * 1024 + lo;
        rowsel = lane;
    }
    __device__ __forceinline__ void set(const bf16_t* A, int lda, const bf16_t* B, int ldb) {
        Ab = (const char*)A; Bb = (const char*)B;
#pragma unroll
        for (int i = 0; i < GA; ++i) { int R, C; stage_rc(wid * 1024 + i * 8192 + rowsel * 16, R, C); offA[i] = (unsigned)(R * lda + C) * 2u; }
#pragma unroll
        for (int i = 0; i < GB; ++i) { int R, C; stage_rc(wid * 1024 + i * 8192 + rowsel * 16, R, C); offB[i] = (unsigned)(R * ldb + C) * 2u; }
    }
    __device__ __forceinline__ void stage_pair(int tp, int buf) {
#pragma unroll
        for (int h = 0; h < 2; ++h) {
#pragma unroll
            for (int i = 0; i < GA; ++i) __builtin_amdgcn_global_load_lds((const unsigned*)(Ab + offA[i] + (2 * tp + h) * 64), (LDSP unsigned*)(lds + buf * PAIR + h * STG + wid * 1024 + i * 8192), 16, 0, 0);
#pragma unroll
            for (int i = 0; i < GB; ++i) __builtin_amdgcn_global_load_lds((const unsigned*)(Bb + offB[i] + (2 * tp + h) * 64), (LDSP unsigned*)(lds + buf * PAIR + h * STG + TA + wid * 1024 + i * 8192), 16, 0, 0);
        }
    }
    __device__ __forceinline__ void prefetch() { stage_pair(0, gp & 1); }
    __device__ __forceinline__ void run(int ntp, f32x4 (&acc)[MT][NT]) {
        asm volatile("s_waitcnt vmcnt(0) lgkmcnt(0)" ::: "memory"); __builtin_amdgcn_s_barrier();
        const bool lower = wid >= 4;
        bf16x8 af[MT], bfr[NT];
#define G2_READ(off) do { \
            _Pragma("unroll") for (int m = 0; m < MT; ++m) af[m] = *(const LDSP bf16x8*)(lds + (off) + aoff + m * 1024); \
            _Pragma("unroll") for (int n = 0; n < NT; ++n) bfr[n] = *(const LDSP bf16x8*)(lds + (off) + boff + n * 1024); } while (0)
#define G2_MMA() do { \
            _Pragma("unroll") for (int m = 0; m < MT; ++m) _Pragma("unroll") for (int n = 0; n < NT; ++n) acc[m][n] = __builtin_amdgcn_mfma_f32_16x16x32_bf16(bfr[n], af[m], acc[m][n], 0, 0, 0); } while (0)
#define G2_SB() __builtin_amdgcn_sched_barrier(0)
#define G2_WAITBAR() do { asm volatile("s_waitcnt vmcnt(0) lgkmcnt(0)" ::: "memory"); __builtin_amdgcn_s_barrier(); } while (0)
        if (!lower) {
            for (int tp = 0; tp < ntp; ++tp) {
                const int cur = ((gp + tp) & 1) * PAIR;
                if (tp + 1 < ntp) stage_pair(tp + 1, (gp + tp + 1) & 1);
                G2_READ(cur); G2_SB(); G2_MMA(); G2_SB();
                G2_READ(cur + STG); G2_SB(); G2_MMA(); G2_SB();
                G2_WAITBAR();
            }
        } else {
            {
                const int cur = (gp & 1) * PAIR;
                if (1 < ntp) stage_pair(1, (gp + 1) & 1);
                G2_READ(cur); G2_SB(); G2_MMA(); G2_SB();
                G2_READ(cur + STG); G2_SB();
                G2_WAITBAR();
            }
            for (int tp = 1; tp < ntp; ++tp) {
                const int cur = ((gp + tp) & 1) * PAIR;
                if (tp + 1 < ntp) stage_pair(tp + 1, (gp + tp + 1) & 1);
                G2_SB(); G2_MMA(); G2_SB();
                G2_READ(cur); G2_SB(); G2_MMA(); G2_SB();
                G2_READ(cur + STG); G2_SB();
                G2_WAITBAR();
            }
            G2_MMA();
        }
#undef G2_READ
#undef G2_MMA
#undef G2_SB
#undef G2_WAITBAR
        gp += ntp;
    }
};
template <int MT, int NT>
__device__ __forceinline__ void zero_acc(f32x4 (&acc)[MT][NT]) {
#pragma unroll
    for (int m = 0; m < MT; ++m)
#pragma unroll
        for (int n = 0; n < NT; ++n) acc[m][n] = (f32x4){0.f, 0.f, 0.f, 0.f};
}

namespace pg8 {
#define PG8_LAS __attribute__((address_space(3)))
typedef unsigned short bf16_t;
typedef short bf16x8 __attribute__((ext_vector_type(8)));
typedef float f32x4 __attribute__((ext_vector_type(4)));
typedef unsigned u32x4 __attribute__((ext_vector_type(4)));
constexpr int BM = 256, BK = 64, HALF = 128, HTB = HALF * BK * 2  , STAGE_BYTES = 8 * HTB, NXCD = 8, WGM = 8;

__host__ __device__ __forceinline__ int lds_byte(int r, int c) { const int st = (r >> 4) * 2 + (c >> 5), rr = r & 15, cc = c & 31, ob = rr * 64 + cc * 2; return st * 1024 + (ob ^ (((ob >> 9) & 1) << 5)); }
__host__ __device__ __forceinline__ void stage_rc(int b, int& R, int& C) { const int st = b / 1024, sb = b % 1024, swz = sb ^ (((sb >> 9) & 1) << 5); R = (st >> 1) * 16 + swz / 64; C = (st & 1) * 32 + (swz % 64) / 2; }
__host__ __device__ __forceinline__ int perm32(int rho) { const int n = rho >> 4, i = rho & 15; return 8 * (i >> 2) + 4 * n + (i & 3); }

struct Unit { int pm, pn; };
struct Gemm { const bf16_t* A; const bf16_t* Bt; int M, N, K; int lda = 0; };

struct StaticOrder {
    int nM, nN, nwg, G, c;
    __host__ __device__ void init(int M, int N, int G_, int c_) { nM = M / BM; nN = N / BM; nwg = nM * nN; G = G_; c = c_; }
    __host__ __device__ bool next(int i, Unit& u) const {
        const long L = (long)i * G + c; if (L >= nwg) return false;
        int wgid = (int)L; { const int q = nwg / NXCD, r = nwg % NXCD, xcd = wgid % NXCD, off = wgid / NXCD; wgid = (xcd < r ? xcd * (q + 1) : r * (q + 1) + (xcd - r) * q) + off; }
        const int nig = WGM * nN, gid = wgid / nig, fm = gid * WGM, gsz = (nM - fm) < WGM ? (nM - fm) : WGM;
        u.pm = fm + ((wgid % nig) % gsz); u.pn = (wgid % nig) / gsz; return true;
    }
    __device__ __forceinline__ void a_ready(const Unit&) const {}
    __device__ __forceinline__ void done(const Unit&) const {}
    __device__ __forceinline__ size_t a_off(const Unit&) const { return 0; }
};

template <int ACT, bool VTP = false> struct EpiBf16S {
    static constexpr bool PERM = true, AFTER_DRAIN = false, KEEP_ACC = false;
    bf16_t* O; int ldc; int split_cols; size_t split_stride;
    __device__ __forceinline__ void operator()(const f32x4 (&acc)[2][2][4][2], const Unit& u, int wr, int wc, int fr, int fq) const {
        const int row0 = u.pm * BM + wr * 64 + fr; int colt = u.pn * BM; bf16_t* base = O;
        if (split_cols) { const int t = colt / split_cols; base += (size_t)t * split_stride; colt -= t * split_cols; }
        const int col0 = colt + wc * 32 + 8 * fq;
#pragma unroll
        for (int ai = 0; ai < 2; ++ai)
#pragma unroll
            for (int m = 0; m < 4; ++m) { bf16_t* rowp = base + (size_t)(row0 + ai * HALF + m * 16) * ldc + col0;
#pragma unroll
                for (int bj = 0; bj < 2; ++bj) { f32x4 v0 = acc[ai][bj][m][0], v1 = acc[ai][bj][m][1];
                    if (ACT == 2) { v0 = (f32x4){sigmoidf(v0[0]), sigmoidf(v0[1]), sigmoidf(v0[2]), sigmoidf(v0[3])}; v1 = (f32x4){sigmoidf(v1[0]), sigmoidf(v1[1]), sigmoidf(v1[2]), sigmoidf(v1[3])}; }
                    u32x4 w4; w4.x = pk_bf16(v0[0], v0[1]); w4.y = pk_bf16(v0[2], v0[3]); w4.z = pk_bf16(v1[0], v1[1]); w4.w = pk_bf16(v1[2], v1[3]);
                    if (VTP) { bf16_t* gp = rowp - 8 * fq + bj * HALF; u32x2 a, b; a.x = w4.x; a.y = w4.y; b.x = w4.z; b.y = w4.w; *(u32x2*)(gp + 4 * fq) = a; *(u32x2*)(gp + 16 + 4 * fq) = b; }
                    else *(u32x4*)(rowp + bj * HALF) = w4; } }
    }
};

template <class Epi, class Sched, bool ALIGN_EPI = false, bool SP2 = false>
__device__ __forceinline__ void gemm_phase(PG8_LAS unsigned char* lds, const Gemm g, const Sched& S, const Epi& E) {
    const int tid = otid(), wid = __builtin_amdgcn_readfirstlane(tid >> 6), lane = tid & 63, wr = wid >> 2, wc = wid & 3, fr = lane & 15, fq = lane >> 4;
    const int K = g.K, nt = K / BK, lda = g.lda ? g.lda : g.K;
    unsigned voffA[2], voffB[2];
#pragma unroll
    for (int i = 0; i < 2; ++i) { int R, C; stage_rc(tid * 16 + i * 8192, R, C); const int Rb = Epi::PERM ? ((R & ~31) + perm32(R & 31)) : R;
        voffA[i] = (unsigned)(R * lda + C) * 2u; voffB[i] = (unsigned)(Rb * K + C) * 2u; }
    const size_t kstep = (size_t)(BK * 2);
    const size_t hstep = (size_t)HALF * K * 2;
    const size_t tstep = 2 * hstep;
    const size_t hstepA = (size_t)HALF * lda * 2, tstepA = 2 * hstepA;
    const unsigned ldsw = (unsigned)wid * 1024u;
    const int aoff = lds_byte(wr * 64 + fr, fq * 8), boff = lds_byte(wc * 32 + fr, fq * 8);
#define PG8_SA(b, h) (((b) * 2 + (h)) * HTB)
#define PG8_SB(b, h) ((4 + (b) * 2 + (h)) * HTB)
#define PG8_STAGE(bufoff, gbase, voff) do { _Pragma("unroll") for (int _i = 0; _i < 2; ++_i) \
        __builtin_amdgcn_global_load_lds((const unsigned*)((const char*)(gbase) + (voff)[_i]), (PG8_LAS unsigned*)(lds + (bufoff) + ldsw + _i * 8192), 16, 0, 0); } while (0)
#define PG8_LDA(dst, b, h) do { _Pragma("unroll") for (int m = 0; m < 4; ++m) _Pragma("unroll") for (int k = 0; k < 2; ++k) dst[m][k] = *(const PG8_LAS bf16x8*)(lds + PG8_SA(b, h) + aoff + m * 2048 + k * 1024); } while (0)
#define PG8_LDB(dst, b, h) do { _Pragma("unroll") for (int n = 0; n < 2; ++n) _Pragma("unroll") for (int k = 0; k < 2; ++k) dst[n][k] = *(const PG8_LAS bf16x8*)(lds + PG8_SB(b, h) + boff + n * 2048 + k * 1024); } while (0)
#define PG8_MMA(ai, bj, At, Bt) do { __builtin_amdgcn_s_setprio(1); _Pragma("unroll") for (int m = 0; m < 4; ++m) _Pragma("unroll") for (int n = 0; n < 2; ++n) _Pragma("unroll") for (int k = 0; k < 2; ++k) \
        acc[ai][bj][m][n] = __builtin_amdgcn_mfma_f32_16x16x32_bf16(Bt[n][k], At[m][k], acc[ai][bj][m][n], 0, 0, 0); __builtin_amdgcn_s_setprio(0); } while (0)
#define PG8_WAIT_V(n) asm volatile("s_waitcnt vmcnt(" #n ")" ::: "memory")
#define PG8_WAIT_L(n) asm volatile("s_waitcnt lgkmcnt(" #n ")" ::: "memory")
#define PG8_BAR __builtin_amdgcn_s_barrier()
#define PG8_SCHED __builtin_amdgcn_sched_barrier(0)
    Unit cur, nxt; int ui = 0;
    if (!S.next(0, cur)) return;
    f32x4 acc[2][2][4][2];
#pragma unroll
    for (int a = 0; a < 2; ++a)
#pragma unroll
        for (int b = 0; b < 2; ++b)
#pragma unroll
            for (int m = 0; m < 4; ++m)
#pragma unroll
                for (int n = 0; n < 2; ++n) acc[a][b][m][n] = (f32x4){0.f, 0.f, 0.f, 0.f};
    bf16x8 At[4][2], B0[2][2], B1[2][2];
    const char* cA = (const char*)g.A + (size_t)cur.pm * tstepA + S.a_off(cur); const char* cB = (const char*)g.Bt + (size_t)cur.pn * tstep;
    S.a_ready(cur);
    if constexpr (SP2) {
        PG8_STAGE(PG8_SB(0, 0), cB, voffB); PG8_STAGE(PG8_SB(0, 1), cB + hstep, voffB); PG8_STAGE(PG8_SA(0, 0), cA, voffA); PG8_STAGE(PG8_SA(0, 1), cA + hstepA, voffA);
        if (wr == 1) PG8_BAR;
        PG8_WAIT_V(2); PG8_BAR;
        PG8_STAGE(PG8_SB(1, 0), cB + kstep, voffB); PG8_STAGE(PG8_SA(1, 0), cA + kstep, voffA); PG8_STAGE(PG8_SB(1, 1), cB + hstep + kstep, voffB);
        PG8_WAIT_V(6); PG8_BAR;
    } else {
        PG8_STAGE(PG8_SB(0, 0), cB, voffB); PG8_STAGE(PG8_SA(0, 0), cA, voffA); PG8_STAGE(PG8_SB(0, 1), cB + hstep, voffB); PG8_STAGE(PG8_SA(0, 1), cA + hstepA, voffA);
        if (wr == 1) PG8_BAR;
        PG8_WAIT_V(4); PG8_BAR;
        PG8_STAGE(PG8_SB(1, 0), cB + kstep, voffB); PG8_STAGE(PG8_SA(1, 0), cA + kstep, voffA); PG8_STAGE(PG8_SB(1, 1), cB + hstep + kstep, voffB);
        PG8_WAIT_V(6); PG8_BAR;
    }
    for (;;) {
        const bool has_next = S.next(ui + 1, nxt);
        const char* nA = has_next ? (const char*)g.A + (size_t)nxt.pm * tstepA + S.a_off(nxt) : cA; const char* nB = has_next ? (const char*)g.Bt + (size_t)nxt.pn * tstep : cB;
        for (int t = 0; t < nt; t += 2) {
            const bool last = (t == nt - 2);
            const char* a1 = cA + (size_t)(t + 1) * kstep;
            const char* a2 = last ? nA : cA + (size_t)(t + 2) * kstep; const char* b2 = last ? nB : cB + (size_t)(t + 2) * kstep;
            const char* a3 = a2 + kstep; const char* b3 = b2 + kstep;
            if (last && has_next) S.a_ready(nxt);
            if constexpr (SP2) {
            PG8_LDB(B0, 0, 0); PG8_LDB(B1, 0, 1); PG8_SCHED; PG8_LDA(At, 0, 0); PG8_STAGE(PG8_SA(1, 1), a1 + hstepA, voffA);
            PG8_WAIT_V(8); PG8_WAIT_L(0); PG8_BAR; PG8_MMA(0, 0, At, B0); PG8_MMA(0, 1, At, B1); PG8_BAR; PG8_SCHED;
            PG8_LDA(At, 0, 1); PG8_STAGE(PG8_SB(0, 0), b2, voffB); PG8_STAGE(PG8_SB(0, 1), b2 + hstep, voffB); PG8_STAGE(PG8_SA(0, 0), a2, voffA);
            PG8_WAIT_V(8); PG8_WAIT_L(0); PG8_BAR; PG8_MMA(1, 0, At, B0); PG8_MMA(1, 1, At, B1); PG8_BAR; PG8_SCHED;
            PG8_LDB(B0, 1, 0); PG8_LDB(B1, 1, 1); PG8_SCHED; PG8_LDA(At, 1, 0); PG8_STAGE(PG8_SA(0, 1), a2 + hstepA, voffA);
            PG8_WAIT_V(8); PG8_WAIT_L(0); PG8_BAR; PG8_MMA(0, 0, At, B0); PG8_MMA(0, 1, At, B1); PG8_BAR; PG8_SCHED;
            PG8_LDA(At, 1, 1); PG8_STAGE(PG8_SB(1, 0), b3, voffB); PG8_STAGE(PG8_SB(1, 1), b3 + hstep, voffB); PG8_STAGE(PG8_SA(1, 0), a3, voffA);
            PG8_WAIT_V(8); PG8_WAIT_L(0); PG8_BAR; PG8_MMA(1, 0, At, B0); PG8_MMA(1, 1, At, B1); PG8_BAR; PG8_SCHED;
            } else {
            PG8_LDB(B0, 0, 0); PG8_SCHED; PG8_LDA(At, 0, 0); PG8_STAGE(PG8_SA(1, 1), a1 + hstepA, voffA);
            PG8_WAIT_L(8); PG8_BAR; PG8_WAIT_L(0); PG8_MMA(0, 0, At, B0); PG8_BAR; PG8_SCHED;
            PG8_LDB(B1, 0, 1); PG8_STAGE(PG8_SB(0, 0), b2, voffB);
            PG8_BAR; PG8_WAIT_L(0); PG8_MMA(0, 1, At, B1); PG8_BAR;
            PG8_LDA(At, 0, 1); PG8_STAGE(PG8_SA(0, 0), a2, voffA);
            PG8_BAR; PG8_WAIT_L(0); PG8_MMA(1, 0, At, B0); PG8_BAR; PG8_SCHED;
            PG8_STAGE(PG8_SB(0, 1), b2 + hstep, voffB);
            PG8_WAIT_V(6); PG8_BAR; PG8_MMA(1, 1, At, B1); PG8_BAR;
            PG8_LDB(B0, 1, 0); PG8_SCHED; PG8_LDA(At, 1, 0); PG8_STAGE(PG8_SA(0, 1), a2 + hstepA, voffA);
            PG8_WAIT_L(8); PG8_BAR; PG8_WAIT_L(0); PG8_MMA(0, 0, At, B0); PG8_BAR; PG8_SCHED;
            PG8_LDB(B1, 1, 1); PG8_STAGE(PG8_SB(1, 0), b3, voffB);
            PG8_BAR; PG8_WAIT_L(0); PG8_MMA(0, 1, At, B1); PG8_BAR;
            PG8_LDA(At, 1, 1); PG8_STAGE(PG8_SA(1, 0), a3, voffA);
            PG8_BAR; PG8_WAIT_L(0); PG8_MMA(1, 0, At, B0); PG8_BAR; PG8_SCHED;
            PG8_STAGE(PG8_SB(1, 1), b3 + hstep, voffB);
            PG8_WAIT_V(6); PG8_BAR; PG8_MMA(1, 1, At, B1); PG8_BAR;
            }
        }
        if constexpr (ALIGN_EPI) { if (wr == 0) PG8_BAR; }
        if constexpr (!Epi::AFTER_DRAIN) { E(acc, cur, wr, wc, fr, fq); S.done(cur); }
        if (!has_next) break;
        if constexpr (!Epi::KEEP_ACC) {
#pragma unroll
        for (int a = 0; a < 2; ++a)
#pragma unroll
            for (int b = 0; b < 2; ++b)
#pragma unroll
                for (int m = 0; m < 4; ++m)
#pragma unroll
                    for (int n = 0; n < 2; ++n) acc[a][b][m][n] = (f32x4){0.f, 0.f, 0.f, 0.f};
        }
        cur = nxt; cA = nA; cB = nB; ++ui;
        if constexpr (ALIGN_EPI) { if (wr == 1) PG8_BAR; }
    }
    PG8_WAIT_V(0);
    if constexpr (!ALIGN_EPI) { if (wr == 0) PG8_BAR; }
    PG8_BAR;
    if constexpr (Epi::AFTER_DRAIN) { E.fused(acc, cur, wr, wc, fr, fq, lds, wid, lane); S.done(cur); }
#undef PG8_SA
#undef PG8_SB
#undef PG8_STAGE
#undef PG8_LDA
#undef PG8_LDB
#undef PG8_MMA
#undef PG8_WAIT_V
#undef PG8_WAIT_L
#undef PG8_BAR
#undef PG8_SCHED
}
}

__device__ __forceinline__ void transpose_tile(const float* __restrict__ src, int lds_, int C, int k0, int n0, bf16_t* __restrict__ dst, int ldd, int split, int shift, float* tile) {
    const int tid = otid();
    __syncthreads();
    {
        f32x4 v[8];
#pragma unroll
        for (int j = 0; j < 8; ++j) { const int idx = tid + 512 * j, k = idx >> 6, n = n0 + 4 * (idx & 63);
            v[j] = (n < C) ? *(const f32x4*)(src + (size_t)(k0 + k) * lds_ + n) : (f32x4){0.f, 0.f, 0.f, 0.f}; }
#pragma unroll
        for (int j = 0; j < 8; ++j) { const int idx = tid + 512 * j, k = idx >> 6, nl = 4 * (idx & 63);
            tile[k * 257 + nl] = v[j][0]; tile[k * 257 + nl + 1] = v[j][1]; tile[k * 257 + nl + 2] = v[j][2]; tile[k * 257 + nl + 3] = v[j][3]; }
    }
    __syncthreads();
    {
#pragma unroll
        for (int it2 = 0; it2 < 4; ++it2) {
            const int q = it2 * 512 + tid, ko = q & 7, nl = q >> 3, n = n0 + nl;
            if (n < C) {
                const int dn = split == 1 ? (n < 512 ? n : n < 768 ? n + 2048 : n < 2816 ? n - 256 : n < NS1 ? n : n + (NWG - NS1)) : n;
                u32x4 o;
                o.x = pk_bf16(tile[(8 * ko + 0) * 257 + nl], tile[(8 * ko + 1) * 257 + nl]);
                o.y = pk_bf16(tile[(8 * ko + 2) * 257 + nl], tile[(8 * ko + 3) * 257 + nl]);
                o.z = pk_bf16(tile[(8 * ko + 4) * 257 + nl], tile[(8 * ko + 5) * 257 + nl]);
                o.w = pk_bf16(tile[(8 * ko + 6) * 257 + nl], tile[(8 * ko + 7) * 257 + nl]);
                *(u32x4*)(dst + (size_t)dn * ldd + k0 + 8 * ko) = o;
            }
        }
    }
}

__device__ __forceinline__ void phase_prepass(const Params& p, char* smem) {
    float* tile = (float*)smem;
    const int nb = onb(), bid = obid(), tid = otid();
    constexpr int T_IN = 16 * 24, T_UP = 3 * 4 * 4, T_OUT = 16 * 4, T_L = T_IN + T_UP + T_OUT;
    for (int v = bid; v < 2 * T_L; v += nb) {
        const int l = v / T_L; int t = v % T_L;
        if (t < T_IN) {
            const int kt = t % 16, nt = t / 16;
            transpose_tile(p.w_in + (size_t)l * 1024 * NIN, NIN, NIN, kt * 64, nt * 256, (bf16_t*)(p.ws + OFF_WT_IN + l * SZ_WT_IN), 1024, 1, 0, tile);
        } else if (t < T_IN + T_UP) {
            t -= T_IN; const int br = t / 16, r = t % 16, kt = r % 4, nt = r / 4;
            transpose_tile(p.w_up + ((size_t)l * 3 + br) * 256 * 1024, 1024, 1024, kt * 64, nt * 256, (bf16_t*)(p.ws + OFF_WT_UP + l * SZ_WT_UP) + (size_t)br * 1024 * 256, 256, 1 << 30, 0, tile);
        } else {
            t -= T_IN + T_UP; const int kt = t % 16, nt = t / 16;
            transpose_tile(p.w_out + (size_t)l * 1024 * 1024, 1024, 1024, kt * 64, nt * 256, (bf16_t*)(p.ws + OFF_WT_OUT + l * SZ_WT_OUT), 1024, 1 << 30, 0, tile);
        }
    }
    {
        const f32x4* xs = (const f32x4*)p.x; u32x2* xd = (u32x2*)(p.ws + OFF_XB);
        const int stride = nb * NTH;
        int i = bid * NTH + tid;
        for (; i + 3 * stride < M_ * 256; i += 4 * stride) {
            f32x4 v[4];
#pragma unroll
            for (int j = 0; j < 4; ++j) v[j] = xs[i + j * stride];
#pragma unroll
            for (int j = 0; j < 4; ++j) { u32x2 o; o.x = pk_bf16(v[j][0], v[j][1]); o.y = pk_bf16(v[j][2], v[j][3]); xd[i + j * stride] = o; }
        }
        for (; i < M_ * 256; i += stride) { const f32x4 v = xs[i]; u32x2 o; o.x = pk_bf16(v[0], v[1]); o.y = pk_bf16(v[2], v[3]); xd[i] = o; }
    }
}

__device__ __forceinline__ void phase_inproj(const Params& p, int layer, char* smem) {
    const bf16_t* xb = (const bf16_t*)(p.ws + OFF_XB);
    const bf16_t* wt = (const bf16_t*)(p.ws + OFF_WT_IN + layer * SZ_WT_IN);
    bf16_t* proj = (bf16_t*)(p.ws + OFF_PROJ);
    bf16_t* vt = (bf16_t*)(p.ws + OFF_VT);
    const int tid = otid(), lane = tid & 63, w = tid >> 6, fr = lane & 15, fq = lane >> 4;
    {
        pg8::Gemm g; g.A = xb; g.Bt = wt; g.M = M_; g.N = NP; g.K = 1024;
        pg8::StaticOrder S; S.init(M_, NP, onb(), obid());
        pg8::EpiBf16S<0> E; E.O = proj; E.ldc = NP; E.split_cols = 0; E.split_stride = 0;
        __syncthreads();
        pg8::gemm_phase<pg8::EpiBf16S<0>, pg8::StaticOrder, true, true>((PG8_LAS unsigned char*)smem, g, S, E);
    }
    {
        pg8::Gemm g; g.A = wt + (size_t)R_AV * 1024; g.Bt = xb; g.M = 256; g.N = M_; g.K = 1024;
        const int first = (M_ / 256) * (NP / 256) % onb();
        pg8::StaticOrder S; S.init(256, M_, onb(), (obid() + onb() - first) % onb());
        pg8::EpiBf16S<0, true> E; E.O = vt; E.ldc = T_; E.split_cols = T_; E.split_stride = (size_t)256 * T_;
        __syncthreads();
        pg8::gemm_phase<pg8::EpiBf16S<0, true>, pg8::StaticOrder, true, true>((PG8_LAS unsigned char*)smem, g, S, E);
    }
    {
        const int start = (640 + 64) % onb();
        const int nidle = onb() - start, r = (obid() + onb() - start) % onb();
        float* cr = (float*)(p.ws + OFF_CR);
        if (r < nidle)
        for (int g16 = r * 8 + w; g16 < M_ / 16; g16 += nidle * 8) {
            const bf16_t* ap = xb + (size_t)(g16 * 16 + fr) * 1024 + fq * 8;
            const bf16_t* bp = wt + (size_t)(C_CR + fr) * 1024 + fq * 8;
            f32x4 a4 = (f32x4){0.f, 0.f, 0.f, 0.f};
#pragma unroll 8
            for (int kk = 0; kk < 32; ++kk) a4 = __builtin_amdgcn_mfma_f32_16x16x32_bf16(*(const bf16x8*)(bp + kk * 32), *(const bf16x8*)(ap + kk * 32), a4, 0, 0, 0);
            *(f32x4*)(cr + (size_t)(g16 * 16 + fr) * 16 + 4 * fq) = a4;
        }
    }
}

__device__ __forceinline__ void attn_item(const Params& p, int item) {
    const bf16_t* proj = (const bf16_t*)(p.ws + OFF_PROJ);
    const bf16_t* vt = (const bf16_t*)(p.ws + OFF_VT);
    bf16_t* Y = (bf16_t*)(p.ws + OFF_Y);
    const int lane = otid() & 63, r = lane & 31, g = lane >> 5;
    const int qb = item & 255, bh = item >> 8, b = bh >> 2, h = bh & 3, t0 = qb * 32;
    const bf16_t* qrow = proj + (size_t)(b * T_ + t0 + r) * NP + C_AQ + h * 64 + 8 * g;
    bf16x8 qf[4];
#pragma unroll
    for (int kk = 0; kk < 4; ++kk) qf[kk] = *(const bf16x8*)(qrow + 16 * kk);
    f32x16 o0, o1;
#pragma unroll
    for (int i = 0; i < 16; ++i) { o0[i] = 0.f; o1[i] = 0.f; }
    float R = 0.f;
    const bf16_t* kbase = proj + (size_t)(b * T_) * NP + C_AK + h * 64 + 8 * g;
    const bf16_t* vtb = vt + (size_t)(bh * 64) * T_;
    const float CS = 0.125f * LOG2E;
#define ATT_LOAD(KF, V0, V1, JB) do { const int s0_ = (JB) * 32; \
        _Pragma("unroll") for (int kk = 0; kk < 4; ++kk) KF[kk] = *(const bf16x8*)(kbase + (size_t)(s0_ + r) * NP + 16 * kk); \
        _Pragma("unroll") for (int dt = 0; dt < 2; ++dt) { const bf16_t* vp = vtb + (size_t)(32 * dt + r) * T_ + s0_ + 16 * g; const u32x4 lo_ = *(const u32x4*)vp, hi_ = *(const u32x4*)(vp + 8); \
            V0[0][dt].x = lo_.x; V0[0][dt].y = lo_.y; V1[0][dt].x = lo_.z; V1[0][dt].y = lo_.w; V0[1][dt].x = hi_.x; V0[1][dt].y = hi_.y; V1[1][dt].x = hi_.z; V1[1][dt].y = hi_.w; } } while (0)
    bf16x8 kf[4]; u32x2 v00[2][2], v01[2][2];
    ATT_LOAD(kf, v00, v01, qb);
    for (int jb = qb; ; --jb) {
        bf16x8 kfn[4]; u32x2 v00n[2][2], v01n[2][2];
        if (jb > 0) ATT_LOAD(kfn, v00n, v01n, jb - 1);
        else {
#pragma unroll
            for (int kk = 0; kk < 4; ++kk) kfn[kk] = kf[kk];
#pragma unroll
            for (int ks = 0; ks < 2; ++ks)
#pragma unroll
                for (int dt = 0; dt < 2; ++dt) { v00n[ks][dt] = v00[ks][dt]; v01n[ks][dt] = v01[ks][dt]; }
        }
        f32x16 z;
#pragma unroll
        for (int i = 0; i < 16; ++i) z[i] = 0.f;
#pragma unroll
        for (int kk = 0; kk < 4; ++kk) z = __builtin_amdgcn_mfma_f32_32x32x16_bf16(kf[kk], qf[kk], z, 0, 0, 0);
        float sp[16], lw[16];
        const bool diag = (jb == qb);
#pragma unroll
        for (int i = 0; i < 16; ++i) {
            const float zs = fminf(z[i] * CS, 60.f);
            const float e = ex2(zs);
            float s = lg2(1.f + e);
            lw[i] = zs - s;
            if (diag) { const int sl = 8 * (i >> 2) + 4 * g + (i & 3); if (sl >= r) { s = 0.f; lw[i] = -1e30f; } }
            sp[i] = s;
        }
        float G[4], O[4];
#pragma unroll
        for (int a = 0; a < 4; ++a) { G[a] = (sp[4 * a] + sp[4 * a + 1]) + (sp[4 * a + 2] + sp[4 * a + 3]); O[a] = __shfl_xor(G[a], 32); }
        float Saf[4];
        Saf[3] = 0.f; Saf[2] = G[3] + O[3]; Saf[1] = Saf[2] + G[2] + O[2]; Saf[0] = Saf[1] + G[1] + O[1];
        const float total = Saf[0] + G[0] + O[0];
        float wgt[16];
#pragma unroll
        for (int a = 0; a < 4; ++a) {
            float tail = Saf[a] + (g == 0 ? O[a] : 0.f) + R;
#pragma unroll
            for (int c = 3; c >= 0; --c) { wgt[4 * a + c] = ex2(lw[4 * a + c] - tail); tail += sp[4 * a + c]; }
        }
        R += total;
#pragma unroll
        for (int ks = 0; ks < 2; ++ks) {
            union { bf16x8 v; unsigned u[4]; } pf;
#pragma unroll
            for (int j = 0; j < 4; ++j) pf.u[j] = pk_bf16(wgt[8 * ks + 2 * j], wgt[8 * ks + 2 * j + 1]);
            union { bf16x8 v; unsigned u[4]; } va, vb;
            va.u[0] = v00[ks][0].x; va.u[1] = v00[ks][0].y; va.u[2] = v01[ks][0].x; va.u[3] = v01[ks][0].y;
            vb.u[0] = v00[ks][1].x; vb.u[1] = v00[ks][1].y; vb.u[2] = v01[ks][1].x; vb.u[3] = v01[ks][1].y;
            o0 = __builtin_amdgcn_mfma_f32_32x32x16_bf16(va.v, pf.v, o0, 0, 0, 0);
            o1 = __builtin_amdgcn_mfma_f32_32x32x16_bf16(vb.v, pf.v, o1, 0, 0, 0);
        }
        if (jb == 0 || __all(R > 151.f)) break;
#pragma unroll
        for (int kk = 0; kk < 4; ++kk) kf[kk] = kfn[kk];
#pragma unroll
        for (int ks = 0; ks < 2; ++ks)
#pragma unroll
            for (int dt = 0; dt < 2; ++dt) { v00[ks][dt] = v00n[ks][dt]; v01[ks][dt] = v01n[ks][dt]; }
    }
#undef ATT_LOAD
    const size_t tok = (size_t)(b * T_ + t0 + r);
    u32x2 agv[2][4];
#pragma unroll
    for (int dt = 0; dt < 2; ++dt)
#pragma unroll
        for (int a = 0; a < 4; ++a) agv[dt][a] = *(const u32x2*)(proj + tok * NP + C_AG + h * 64 + 32 * dt + 8 * a + 4 * g);
#pragma unroll
    for (int dt = 0; dt < 2; ++dt)
#pragma unroll
        for (int a = 0; a < 4; ++a) {
            const int d = 32 * dt + 8 * a + 4 * g;
            const u32x2 gv = agv[dt][a];
            const float o_0 = dt ? o1[4 * a + 0] : o0[4 * a + 0], o_1 = dt ? o1[4 * a + 1] : o0[4 * a + 1], o_2 = dt ? o1[4 * a + 2] : o0[4 * a + 2], o_3 = dt ? o1[4 * a + 3] : o0[4 * a + 3];
            u32x2 ov; ov.x = pk_bf16(o_0 * siluf(bflo(gv.x)), o_1 * siluf(bfhi(gv.x))); ov.y = pk_bf16(o_2 * siluf(bflo(gv.y)), o_3 * siluf(bfhi(gv.y)));
            *(u32x2*)(Y + tok * 768 + h * 64 + d) = ov;
        }
}

template <int DK, bool HG>
__device__ __forceinline__ void rec_prologue(const Params& p, int layer, int b, int h, int c, char* smem) {
    float* cumS = (float*)smem; float* keyS = (float*)(smem + 17408); bf16_t* vT = (bf16_t*)(smem + 34816); float* part = (float*)(smem + 53248);
    const bf16_t* proj = (const bf16_t*)(p.ws + OFF_PROJ);
    const int tid = otid() & 255;
    constexpr int NG = 256 / DK, TPG = 64 / NG;
    const int k = tid % DK, grp = tid / DK;
    const size_t tokb = (size_t)b * T_ + c * 64;
    const int sV = tid >> 2, vcV = (tid & 3) * 16;
    const bf16_t* vpV = proj + (tokb + sV) * NP + (HG ? C_HI : C_CV) + h * 64 + vcV;
    const u32x4 a0V = *(const u32x4*)vpV, a1V = *(const u32x4*)(vpV + 8);
    bf16_t zr[TPG]; f32x4 crv[HG ? 1 : TPG][4];
    if (HG) {
#pragma unroll
        for (int i = 0; i < TPG; ++i) zr[i] = proj[(tokb + grp * TPG + i) * NP + C_HF + h * 64 + k];
    } else {
#pragma unroll
        for (int i = 0; i < TPG; ++i) {
            const f32x4* crp = (const f32x4*)((const float*)(p.ws + OFF_CR) + (tokb + grp * TPG + i) * 16);
            crv[i][0] = crp[0]; crv[i][1] = crp[1]; crv[i][2] = crp[2]; crv[i][3] = crp[3];
            zr[i] = proj[(tokb + grp * TPG + i) * NP + C_CK + h * 32 + k];
        }
    }
    __syncthreads();
    float run = 0.f;
    if (HG) {
        float lbv = 0.f;
        if (layer > 0) { float mx = -1e30f; for (int i = 0; i < 2; ++i) mx = fmaxf(mx, p.lbl[i * 256 + h * 64 + k]); float den = 0.f, num = 0.f;
            for (int i = 0; i < 2; ++i) { const float e = exn(p.lbl[i * 256 + h * 64 + k] - mx); den += e; if (i >= 1 && i <= layer) num += e; } lbv = num / den; }
#pragma unroll
        for (int i = 0; i < TPG; ++i) {
            const int s = grp * TPG + i;
            const float zf = bf2f(zr[i]);
            const float lf = logsigmoidf(zf) + lgn(1.f + lbv * exn(fminf(-zf, 60.f)));
            const float key = (1.f - lbv) * sigmoidf(-zf);
            run += lf; cumS[s * (DK + 1) + k] = run; keyS[s * (DK + 1) + k] = key;
        }
    } else {
        float w2r[16];
#pragma unroll
        for (int r = 0; r < 16; ++r) w2r[r] = p.w2[((size_t)layer * 16 + r) * 128 + h * 32 + k];
        const float bias = p.gb[layer * 128 + h * 32 + k];
#pragma unroll
        for (int i = 0; i < TPG; ++i) {
            const int s = grp * TPG + i;
            const f32x4 c0 = crv[HG ? 0 : i][0], c1 = crv[HG ? 0 : i][1], c2 = crv[HG ? 0 : i][2], c3 = crv[HG ? 0 : i][3];
            float gp = bias;
            gp += c0[0] * w2r[0] + c0[1] * w2r[1] + c0[2] * w2r[2] + c0[3] * w2r[3] + c1[0] * w2r[4] + c1[1] * w2r[5] + c1[2] * w2r[6] + c1[3] * w2r[7];
            gp += c2[0] * w2r[8] + c2[1] * w2r[9] + c2[2] * w2r[10] + c2[3] * w2r[11] + c3[0] * w2r[12] + c3[1] * w2r[13] + c3[2] * w2r[14] + c3[3] * w2r[15];
            const float lf = logsigmoidf(gp) * (1.f / 16.f);
            const float key = bf2f(zr[i]);
            run += lf; cumS[s * (DK + 1) + k] = run; keyS[s * (DK + 1) + k] = key;
        }
    }
    part[grp * 64 + k] = run;
    {
        const int s = sV, vc = vcV; const u32x4 a0 = a0V, a1 = a1V;
        const unsigned uu[8] = {a0.x, a0.y, a0.z, a0.w, a1.x, a1.y, a1.z, a1.w};
#pragma unroll
        for (int e = 0; e < 8; ++e) { vT[(vc + 2 * e) * LROW + s] = (bf16_t)(uu[e] & 0xffffu); vT[(vc + 2 * e + 1) * LROW + s] = (bf16_t)(uu[e] >> 16); }
    }
    __syncthreads();
    float pre = 0.f;
    for (int g2 = 0; g2 < grp; ++g2) pre += part[g2 * 64 + k];
#pragma unroll 4
    for (int i = 0; i < TPG; ++i) cumS[(grp * TPG + i) * (DK + 1) + k] += pre;
    __syncthreads();
}

__device__ __forceinline__ void rec_stepB(const Params& p, int item) {
    if (otid() >= 256) return;
    const int eg0 = item * 256 + otid();
    const bool hgr = eg0 < 32768;
    const int eg = hgr ? eg0 : eg0 - 32768;
    const int DK = hgr ? 64 : 32;
    const int bh = eg / (64 * DK), e = eg % (64 * DK), k = e % DK;
    const float* sloc = (const float*)(p.ws + (hgr ? OFF_SLOC_H : OFF_SLOC_G)) + (size_t)bh * 128 * 64 * DK + e;
    const float* dec = (const float*)(p.ws + (hgr ? OFF_DEC_H : OFF_DEC_G)) + (size_t)bh * 128 * DK + k;
    bf16_t* sst = (bf16_t*)(p.ws + (hgr ? OFF_SST_H : OFF_SST_G)) + (size_t)bh * 128 * 64 * DK + e;
    const int cs = 64 * DK;
    float S = 0.f;
    for (int c0 = 0; c0 < 128; c0 += 32) {
        float sl[32], dc[32];
#pragma unroll
        for (int j = 0; j < 32; ++j) { sl[j] = sloc[(size_t)(c0 + j) * cs]; dc[j] = dec[(c0 + j) * DK]; }
#pragma unroll
        for (int j = 0; j < 32; ++j) { sst[(size_t)(c0 + j) * cs] = f2bf(S); S = dc[j] * S + sl[j]; }
    }
}

template <int DK, bool HG>
__device__ __forceinline__ void rec_pass1(const Params& p, int layer, int pair, char* smem) {
    const int item = 2 * pair + (otid() >> 8); smem += (otid() >> 8) * REC_LDS;
    const int c = item & 127, bh = item >> 7, b = bh >> 2, h = bh & 3;
    const bf16_t* proj = (const bf16_t*)(p.ws + OFF_PROJ);
    const int tid = otid() & 255, lane = tid & 63, w = (otid() >> 8) ? 3 - (tid >> 6) : (tid >> 6), fr = lane & 15, fq = lane >> 4;
    constexpr int NKK = DK / 32;
    const size_t tok = (size_t)b * T_ + c * 64 + 16 * w + fr;
    const float qscale = HG ? 1.f : 0.17677669529663687f;
    const int trow = 16 * w + fr;
    u32x4 qrv[NKK];
#pragma unroll
    for (int kk = 0; kk < NKK; ++kk) qrv[kk] = *(const u32x4*)(proj + tok * NP + (HG ? C_HQ : C_CQ) + h * DK + 32 * kk + 8 * fq);
    rec_prologue<DK, HG>(p, layer, b, h, c, smem);
    const float* cumS = (const float*)smem; const float* keyS = (const float*)(smem + 17408); const bf16_t* vT = (const bf16_t*)(smem + 34816);
    bf16x8 Qt[NKK], Qh[NKK];
    float ref[NKK][8];
#pragma unroll
    for (int kk = 0; kk < NKK; ++kk) {
        const u32x4 qr = qrv[kk];
        const unsigned qq[4] = {qr.x, qr.y, qr.z, qr.w};
        union { bf16x8 v; unsigned u[4]; } ut, uh;
#pragma unroll
        for (int e2 = 0; e2 < 4; ++e2) {
            const int k0 = 32 * kk + 8 * fq + 2 * e2;
            const float r0 = w ? cumS[(16 * w - 1) * (DK + 1) + k0] : 0.f, r1 = w ? cumS[(16 * w - 1) * (DK + 1) + k0 + 1] : 0.f;
            ref[kk][2 * e2] = r0; ref[kk][2 * e2 + 1] = r1;
            const float c0 = cumS[trow * (DK + 1) + k0], c1 = cumS[trow * (DK + 1) + k0 + 1];
            const float q0 = bflo(qq[e2]) * qscale, q1 = bfhi(qq[e2]) * qscale;
            ut.u[e2] = pk_bf16(q0 * exn(c0 - r0), q1 * exn(c1 - r1));
            uh.u[e2] = pk_bf16(q0 * exn(c0), q1 * exn(c1));
        }
        Qt[kk] = ut.v; Qh[kk] = uh.v;
    }
    f32x4 sT[4];
#pragma unroll
    for (int j = 0; j < 4; ++j) {
        sT[j] = (f32x4){0.f, 0.f, 0.f, 0.f};
        if (j <= w) {
            const int srow = 16 * j + fr;
#pragma unroll
            for (int kk = 0; kk < NKK; ++kk) {
                union { bf16x8 v; unsigned u[4]; } kt;
#pragma unroll
                for (int e2 = 0; e2 < 4; ++e2) {
                    const int k0 = 32 * kk + 8 * fq + 2 * e2;
                    const float a0 = keyS[srow * (DK + 1) + k0] * exn(fminf(ref[kk][2 * e2] - cumS[srow * (DK + 1) + k0], 80.f));
                    const float a1 = keyS[srow * (DK + 1) + k0 + 1] * exn(fminf(ref[kk][2 * e2 + 1] - cumS[srow * (DK + 1) + k0 + 1], 80.f));
                    kt.u[e2] = pk_bf16(a0, a1);
                }
                sT[j] = __builtin_amdgcn_mfma_f32_16x16x32_bf16(kt.v, Qt[kk], sT[j], 0, 0, 0);
            }
            if (j == w) {
#pragma unroll
                for (int r = 0; r < 4; ++r) if (4 * fq + r > fr) sT[j][r] = 0.f;
            }
        }
    }
    f32x4 o[4];
#pragma unroll
    for (int vt = 0; vt < 4; ++vt) o[vt] = (f32x4){0.f, 0.f, 0.f, 0.f};
#pragma unroll
    for (int pr = 0; pr < 2; ++pr) {
        if (2 * pr <= w) {
            union { bf16x8 v; unsigned u[4]; } pf;
            pf.u[0] = pk_bf16(sT[2 * pr][0], sT[2 * pr][1]); pf.u[1] = pk_bf16(sT[2 * pr][2], sT[2 * pr][3]);
            pf.u[2] = pk_bf16(sT[2 * pr + 1][0], sT[2 * pr + 1][1]); pf.u[3] = pk_bf16(sT[2 * pr + 1][2], sT[2 * pr + 1][3]);
#pragma unroll
            for (int vt = 0; vt < 4; ++vt) {
                const bf16_t* vp = vT + (16 * vt + fr) * LROW + 32 * pr + 4 * fq;
                const u32x2 x0 = *(const u32x2*)vp, x1 = *(const u32x2*)(vp + 16);
                union { bf16x8 v; unsigned u[4]; } af; af.u[0] = x0.x; af.u[1] = x0.y; af.u[2] = x1.x; af.u[3] = x1.y;
                o[vt] = __builtin_amdgcn_mfma_f32_16x16x32_bf16(af.v, pf.v, o[vt], 0, 0, 0);
            }
        }
    }
    {
        bf16_t* OI = (bf16_t*)(p.ws + OFF_OI) + tok * 512 + (HG ? 0 : 256) + h * 64;
#pragma unroll
        for (int vt = 0; vt < 4; ++vt) { u32x2 ov; ov.x = pk_bf16(o[vt][0], o[vt][1]); ov.y = pk_bf16(o[vt][2], o[vt][3]); *(u32x2*)(OI + 16 * vt + 4 * fq) = ov; }
        bf16_t* QH = (bf16_t*)(p.ws + OFF_QH) + tok * 384 + (HG ? h * 64 : 256 + h * 32);
#pragma unroll
        for (int kk = 0; kk < NKK; ++kk) *(bf16x8*)(QH + 32 * kk + 8 * fq) = Qh[kk];
    }
    {
        bf16_t* khT = (bf16_t*)(smem + 44032);
        constexpr int NG = 256 / DK, TPG = 64 / NG;
        {
            const int k = tid % DK, grp = tid / DK; const float last = cumS[63 * (DK + 1) + k];
#pragma unroll 4
            for (int i = 0; i < TPG; ++i) { const int s2 = grp * TPG + i; khT[k * LROW + s2] = f2bf(keyS[s2 * (DK + 1) + k] * exn(last - cumS[s2 * (DK + 1) + k])); }
        }
        __syncthreads();
        f32x4 accS[DK / 16];
#pragma unroll
        for (int n = 0; n < DK / 16; ++n) accS[n] = (f32x4){0.f, 0.f, 0.f, 0.f};
#pragma unroll
        for (int ks = 0; ks < 2; ++ks) {
            const bf16x8 a = *(const bf16x8*)(vT + (16 * w + fr) * LROW + 32 * ks + 8 * fq);
#pragma unroll
            for (int n = 0; n < DK / 16; ++n) { const bf16x8 bb = *(const bf16x8*)(khT + (16 * n + fr) * LROW + 32 * ks + 8 * fq); accS[n] = __builtin_amdgcn_mfma_f32_16x16x32_bf16(a, bb, accS[n], 0, 0, 0); }
        }
        float* sloc = (float*)(p.ws + (HG ? OFF_SLOC_H : OFF_SLOC_G)) + (size_t)(bh * 128 + c) * 64 * DK;
#pragma unroll
        for (int n = 0; n < DK / 16; ++n)
#pragma unroll
            for (int r = 0; r < 4; ++r) sloc[(16 * w + 4 * fq + r) * DK + 16 * n + fr] = accS[n][r];
        float* dec = (float*)(p.ws + (HG ? OFF_DEC_H : OFF_DEC_G)) + (size_t)(bh * 128 + c) * DK;
        if (tid < DK) dec[tid] = exn(cumS[63 * (DK + 1) + tid]);
    }
}

template <int DK, bool HG>
__device__ __forceinline__ void rec_pass2(const Params& p, int layer, int witem) {
    const int lane = otid() & 63, fr = lane & 15, fq = lane >> 4;
    constexpr int NKK = DK / 32;
    const int tg = witem & 511, bh = witem >> 9, b = bh >> 2, h = bh & 3, c = tg >> 2;
    const size_t tok = (size_t)b * T_ + tg * 16 + fr;
    const bf16_t* proj = (const bf16_t*)(p.ws + OFF_PROJ);
    const float* gain = (HG ? p.hg : p.gg) + layer * 256 + h * 64;
    const bf16_t* sst = (const bf16_t*)(p.ws + (HG ? OFF_SST_H : OFF_SST_G)) + (size_t)(bh * 128 + c) * 64 * DK;
    const bf16_t* OI = (const bf16_t*)(p.ws + OFF_OI) + tok * 512 + (HG ? 0 : 256) + h * 64;
    const bf16_t* QH = (const bf16_t*)(p.ws + OFF_QH) + tok * 384 + (HG ? h * 64 : 256 + h * 32);
    bf16x8 Qh[NKK], sstv[4][NKK]; u32x2 gvv[4], oiv[4]; f32x4 gnv[4];
#pragma unroll
    for (int kk = 0; kk < NKK; ++kk) Qh[kk] = *(const bf16x8*)(QH + 32 * kk + 8 * fq);
#pragma unroll
    for (int vt = 0; vt < 4; ++vt) {
        oiv[vt] = *(const u32x2*)(OI + 16 * vt + 4 * fq);
        gvv[vt] = *(const u32x2*)(proj + tok * NP + (HG ? C_HG : C_CG) + h * 64 + 16 * vt + 4 * fq);
        gnv[vt] = *(const f32x4*)(gain + 16 * vt + 4 * fq);
#pragma unroll
        for (int kk = 0; kk < NKK; ++kk) sstv[vt][kk] = *(const bf16x8*)(sst + (16 * vt + fr) * DK + 32 * kk + 8 * fq);
    }
    f32x4 o[4];
#pragma unroll
    for (int vt = 0; vt < 4; ++vt) {
        o[vt] = (f32x4){bflo(oiv[vt].x), bfhi(oiv[vt].x), bflo(oiv[vt].y), bfhi(oiv[vt].y)};
#pragma unroll
        for (int kk = 0; kk < NKK; ++kk) o[vt] = __builtin_amdgcn_mfma_f32_16x16x32_bf16(sstv[vt][kk], Qh[kk], o[vt], 0, 0, 0);
    }
    float ss = 0.f;
#pragma unroll
    for (int vt = 0; vt < 4; ++vt)
#pragma unroll
        for (int r = 0; r < 4; ++r) ss += o[vt][r] * o[vt][r];
    ss += __shfl_xor(ss, 16); ss += __shfl_xor(ss, 32);
    const float rinv = rsqrtf(ss * (1.f / 64.f) + EPS);
    bf16_t* Y = (bf16_t*)(p.ws + OFF_Y);
#pragma unroll
    for (int vt = 0; vt < 4; ++vt) {
        const int v = 16 * vt + 4 * fq;
        const u32x2 gv = gvv[vt];
        const f32x4 gn = gnv[vt];
        u32x2 ov;
        ov.x = pk_bf16(o[vt][0] * rinv * gn[0] * siluf(bflo(gv.x)), o[vt][1] * rinv * gn[1] * siluf(bfhi(gv.x)));
        ov.y = pk_bf16(o[vt][2] * rinv * gn[2] * siluf(bflo(gv.y)), o[vt][3] * rinv * gn[3] * siluf(bfhi(gv.y)));
        *(u32x2*)(Y + tok * 768 + (HG ? 256 : 512) + h * 64 + v) = ov;
    }
}

struct OwnOrder {
    int pm, j, ok;
    __device__ __forceinline__ bool next(int i, pg8::Unit& u) const { if (!ok || i >= 3) return false; u.pm = pm; u.pn = j + 4 * i; return true; }
    __device__ __forceinline__ void a_ready(const pg8::Unit&) const {}
    __device__ __forceinline__ void done(const pg8::Unit&) const {}
    __device__ __forceinline__ size_t a_off(const pg8::Unit&) const { return 0; }
};
__device__ __forceinline__ void phase_gates(const Params& p, int layer, char* smem) {
    pg8::Gemm g; g.A = (const bf16_t*)(p.ws + OFF_XB); g.Bt = (const bf16_t*)(p.ws + OFF_WT_IN + layer * SZ_WT_IN) + (size_t)NWG * 1024; g.M = M_; g.N = 3072; g.K = 1024;
    OwnOrder S; S.ok = tile_order(obid(), 64, 4, S.pm, S.j) ? 1 : 0;
    pg8::EpiBf16S<2> E; E.O = (bf16_t*)(p.ws + OFF_GATES); E.ldc = 3072; E.split_cols = 0; E.split_stride = 0;
    __syncthreads();
    pg8::gemm_phase<pg8::EpiBf16S<2>, OwnOrder, true, true>((PG8_LAS unsigned char*)smem, g, S, E);
    asm volatile("s_waitcnt vmcnt(0)" ::: "memory");
}

struct UpOrder {
    int pm, j, ok;
    __device__ __forceinline__ bool next(int i, pg8::Unit& u) const { if (!ok || i >= 3) return false; u.pm = pm; u.pn = j + 4 * i; return true; }
    __device__ __forceinline__ void a_ready(const pg8::Unit&) const {}
    __device__ __forceinline__ void done(const pg8::Unit&) const {}
    __device__ __forceinline__ size_t a_off(const pg8::Unit& u) const { return (size_t)(u.pn >> 2) * 256 * 2; }
};
struct EpiUp {
    static constexpr bool PERM = true, AFTER_DRAIN = false, KEEP_ACC = true;
    bf16_t* gates; bf16_t* mg;
    __device__ __forceinline__ void operator()(f32x4 (&acc)[2][2][4][2], const pg8::Unit& u, int wr, int wc, int fr, int fq) const {
        const int n = u.pn >> 2, j = u.pn & 3;
        const int col = j * 256 + wc * 32 + 8 * fq;
        const bf16_t* gbase = gates + (size_t)(u.pm * 256 + wr * 64 + fr) * 3072 + n * 1024 + col;
        bf16_t* mbase = mg + (size_t)(u.pm * 256 + wr * 64 + fr) * 1024 + col;
        const float GMIN = 8.6736174e-19f;
        u32x4 Gq[8][2], Nq[8][2];
#define UP_LOAD(gi_) do { const size_t ro_ = (size_t)(((gi_) >> 2) * 128 + ((gi_) & 3) * 16) * 3072; \
            _Pragma("unroll") for (int bj = 0; bj < 2; ++bj) { Gq[gi_][bj] = *(const u32x4*)(gbase + ro_ + bj * 128); Nq[gi_][bj] = n < 2 ? *(const u32x4*)(gbase + ro_ + 1024 + bj * 128) : (u32x4){0u, 0u, 0u, 0u}; } } while (0)
        UP_LOAD(0); UP_LOAD(1);
#pragma unroll
        for (int gi = 0; gi < 8; ++gi) {
            const int ai = gi >> 2, m = gi & 3;
            if (gi + 2 < 8) UP_LOAD(gi + 2);
            __builtin_amdgcn_sched_barrier(0);
#pragma unroll
            for (int bj = 0; bj < 2; ++bj) {
                const u32x4 g = Gq[gi][bj], q = Nq[gi][bj];
                const unsigned gw[4] = {g.x, g.y, g.z, g.w}, qw[4] = {q.x, q.y, q.z, q.w};
                float r[8];
#pragma unroll
                for (int e = 0; e < 4; ++e) {
                    const float a0 = (e < 2 ? acc[ai][bj][m][0][2 * e] : acc[ai][bj][m][1][2 * e - 4]), a1 = (e < 2 ? acc[ai][bj][m][0][2 * e + 1] : acc[ai][bj][m][1][2 * e - 3]);
                    r[2 * e] = a0 * fmaxf(bflo(gw[e]), GMIN); r[2 * e + 1] = a1 * fmaxf(bfhi(gw[e]), GMIN);
                }
                if (n < 2) {
#pragma unroll
                    for (int e = 0; e < 4; ++e) { r[2 * e] *= __builtin_amdgcn_rcpf(fmaxf(bflo(qw[e]), GMIN)); r[2 * e + 1] *= __builtin_amdgcn_rcpf(fmaxf(bfhi(qw[e]), GMIN)); }
                    acc[ai][bj][m][0] = (f32x4){r[0], r[1], r[2], r[3]}; acc[ai][bj][m][1] = (f32x4){r[4], r[5], r[6], r[7]};
                } else {
                    u32x4 w4; w4.x = pk_bf16(r[0], r[1]); w4.y = pk_bf16(r[2], r[3]); w4.z = pk_bf16(r[4], r[5]); w4.w = pk_bf16(r[6], r[7]);
                    *(u32x4*)(mbase + (size_t)(ai * 128 + m * 16) * 1024 + bj * 128) = w4;
                }
            }
            __builtin_amdgcn_sched_barrier(0);
        }
#undef UP_LOAD
    }
};
__device__ __forceinline__ void phase_upmerge(const Params& p, int layer, char* smem) {
    pg8::Gemm g; g.A = (const bf16_t*)(p.ws + OFF_Y); g.Bt = (const bf16_t*)(p.ws + OFF_WT_UP + layer * SZ_WT_UP); g.M = M_; g.N = 3072; g.K = 256; g.lda = 768;
    UpOrder S; S.ok = tile_order(obid(), 64, 4, S.pm, S.j) ? 1 : 0;
    EpiUp E; E.gates = (bf16_t*)(p.ws + OFF_GATES); E.mg = (bf16_t*)(p.ws + OFF_MERGED);
    __syncthreads();
    pg8::gemm_phase<EpiUp, UpOrder, true, true>((PG8_LAS unsigned char*)smem, g, S, E);
}

struct EpiOutLn {
    static constexpr bool PERM = false, AFTER_DRAIN = true, KEEP_ACC = false;
    const float* resid; float* out; bf16_t* xb; const float* lg; const float* lb; unsigned long long* stats; unsigned* cnt; int write_xb;
    __device__ __forceinline__ void fused(f32x4 (&acc)[2][2][4][2], const pg8::Unit& u, int wr, int wc, int fr, int fq, PG8_LAS unsigned char* lds, int wid, int lane) const {
        PG8_LAS float* P = (PG8_LAS float*)lds;
        PG8_LAS float* S = (PG8_LAS float*)(lds + 8192);
        const int tid = wid * 64 + lane, tm = u.pm, tn = u.pn;
        const int col0 = tn * 256 + wc * 32 + 4 * fq;
        f32x4 lgv[2][2], lbv[2][2];
#pragma unroll
        for (int bj = 0; bj < 2; ++bj)
#pragma unroll
            for (int n = 0; n < 2; ++n) { lgv[bj][n] = *(const f32x4*)(lg + col0 + bj * 128 + n * 16); lbv[bj][n] = *(const f32x4*)(lb + col0 + bj * 128 + n * 16); }
#pragma unroll
        for (int ai = 0; ai < 2; ++ai)
#pragma unroll
            for (int m = 0; m < 4; ++m) {
                const int rl = ai * 128 + wr * 64 + m * 16 + fr; const size_t rowoff = (size_t)(tm * 256 + rl) * 1024 + col0;
                float s1 = 0.f, s2 = 0.f;
#pragma unroll
                for (int bj = 0; bj < 2; ++bj)
#pragma unroll
                    for (int n = 0; n < 2; ++n) { const f32x4 rv = *(const f32x4*)(resid + rowoff + bj * 128 + n * 16); const f32x4 x = rv * ALPHA + acc[ai][bj][m][n]; acc[ai][bj][m][n] = x;
                        s1 += (x[0] + x[1]) + (x[2] + x[3]); s2 += (x[0] * x[0] + x[1] * x[1]) + (x[2] * x[2] + x[3] * x[3]); }
                s1 += __shfl_xor(s1, 16); s1 += __shfl_xor(s1, 32); s2 += __shfl_xor(s2, 16); s2 += __shfl_xor(s2, 32);
                if (fq == 0) { P[(rl * 4 + wc) * 2] = s1; P[(rl * 4 + wc) * 2 + 1] = s2; }
            }
        __syncthreads();
        if (tid < 256) {
            const float a = (P[(tid * 4 + 0) * 2] + P[(tid * 4 + 1) * 2]) + (P[(tid * 4 + 2) * 2] + P[(tid * 4 + 3) * 2]);
            const float b = (P[(tid * 4 + 0) * 2 + 1] + P[(tid * 4 + 1) * 2 + 1]) + (P[(tid * 4 + 2) * 2 + 1] + P[(tid * 4 + 3) * 2 + 1]);
            __hip_atomic_store(stats + ((size_t)(tm * 4 + tn) * 256 + tid), ((unsigned long long)__float_as_uint(b) << 32) | __float_as_uint(a), __ATOMIC_RELAXED, __HIP_MEMORY_SCOPE_AGENT);
        }
        asm volatile("s_waitcnt vmcnt(0)" ::: "memory");
        __syncthreads();
        if (tid == 0) {
            __hip_atomic_fetch_add(cnt + tm, 1u, __ATOMIC_RELEASE, __HIP_MEMORY_SCOPE_AGENT);
            unsigned sp = 0;
            while (__hip_atomic_load(cnt + tm, __ATOMIC_RELAXED, __HIP_MEMORY_SCOPE_AGENT) < 4u) { __builtin_amdgcn_s_sleep(1); if (++sp > (1u << 22)) break; }
            __builtin_amdgcn_fence(__ATOMIC_ACQUIRE, "agent");
            asm volatile("s_waitcnt vmcnt(0)" ::: "memory");
        }
        __syncthreads();
        if (tid < 256) {
            float a = 0.f, b = 0.f;
#pragma unroll
            for (int t = 0; t < 4; ++t) { const unsigned long long pk = __hip_atomic_load(stats + ((size_t)(tm * 4 + t) * 256 + tid), __ATOMIC_RELAXED, __HIP_MEMORY_SCOPE_AGENT);
                a += __uint_as_float((unsigned)pk); b += __uint_as_float((unsigned)(pk >> 32)); }
            const float mean = a * (1.f / 1024.f), var = fmaxf(b * (1.f / 1024.f) - mean * mean, 0.f);
            S[tid * 2] = mean; S[tid * 2 + 1] = rsqrtf(var + EPS);
        }
        __syncthreads();
#pragma unroll
        for (int ai = 0; ai < 2; ++ai)
#pragma unroll
            for (int m = 0; m < 4; ++m) {
                const int rl = ai * 128 + wr * 64 + m * 16 + fr; const float mean = S[rl * 2], rstd = S[rl * 2 + 1];
                const size_t rowoff = (size_t)(tm * 256 + rl) * 1024 + col0;
#pragma unroll
                for (int bj = 0; bj < 2; ++bj)
#pragma unroll
                    for (int n = 0; n < 2; ++n) {
                        const f32x4 gv = lgv[bj][n], bv = lbv[bj][n];
                        const f32x4 y = (acc[ai][bj][m][n] - mean) * rstd * gv + bv;
                        *(f32x4*)(out + rowoff + bj * 128 + n * 16) = y;
                        if (write_xb) { u32x2 o; o.x = pk_bf16(y[0], y[1]); o.y = pk_bf16(y[2], y[3]); *(u32x2*)(xb + rowoff + bj * 128 + n * 16) = o; }
                    }
            }
    }
};
__device__ __forceinline__ void phase_outproj_ln(const Params& p, int layer, char* smem) {
    pg8::Gemm g; g.A = (const bf16_t*)(p.ws + OFF_MERGED); g.Bt = (const bf16_t*)(p.ws + OFF_WT_OUT + layer * SZ_WT_OUT); g.M = M_; g.N = 1024; g.K = 1024;
    pg8::StaticOrder S; S.init(M_, 1024, onb(), obid());
    EpiOutLn E; E.resid = layer == 0 ? p.x : p.out; E.out = p.out; E.xb = (bf16_t*)(p.ws + OFF_XB); E.lg = p.ln_g + layer * 1024; E.lb = p.ln_b + layer * 1024;
    E.stats = (unsigned long long*)(p.ws + OFF_STATS) + (size_t)layer * 64 * 4 * 256; E.cnt = (unsigned*)(p.ws + OFF_BAR) + layer * 64; E.write_xb = layer == 0;
    __syncthreads();
    pg8::gemm_phase<EpiOutLn, pg8::StaticOrder, false, true>((PG8_LAS unsigned char*)smem, g, S, E);
}

#define XB_TMO      128
#define XB_XCNT(j)  (256  + 64 * (j))
#define XB_XSUB(j)  (1280 + 64 * (j))
#define XB_XGEN(j)  (2304 + 64 * (j))
#define XB_TOP      3328
#define XB_TOPGEN   3392
#define XCD_BAR_WORDS 3456
#define XB_SPIN_CAP (1u << 18)
__device__ __forceinline__ unsigned xb_ld(unsigned* p)              { return __hip_atomic_load(p, __ATOMIC_RELAXED, __HIP_MEMORY_SCOPE_AGENT); }
__device__ __forceinline__ unsigned xb_add(unsigned* p, unsigned v) { return __hip_atomic_fetch_add(p, v, __ATOMIC_RELAXED, __HIP_MEMORY_SCOPE_AGENT); }
__device__ __forceinline__ unsigned xb_xcc_id() { return (unsigned)__builtin_amdgcn_s_getreg((3 << 11) | 20) & 0xFu; }
#define XB_SPIN(cond, bar) do { unsigned _sp = 0; while (cond) { __builtin_amdgcn_s_sleep(1); \
    if ((++_sp & 255u) == 0u) { if (xb_ld(&(bar)[XB_TMO])) break; if (_sp > XB_SPIN_CAP) { atomicAdd(&(bar)[XB_TMO], 1u); break; } } } } while (0)
struct XcdBarrier { unsigned* bar; unsigned x; volatile LDSP unsigned* st; };
__device__ __forceinline__ XcdBarrier xcd_barrier_post(unsigned* bar, volatile LDSP unsigned* st) {
    XcdBarrier b; b.bar = bar; b.x = xb_xcc_id(); b.st = st;
    if (threadIdx.x == 0) (void)xb_add(&bar[XB_XCNT(b.x)], 1u);
    return b;
}
__device__ __forceinline__ void xcd_barrier_complete(unsigned* bar, unsigned x, unsigned& nloc, unsigned& nx) {
    const unsigned G = gridDim.x * gridDim.y * gridDim.z;
    unsigned sum, cnt, mine, sp = 0u;
    for (;;) {
        sum = 0u; cnt = 0u; mine = 0u;
#pragma unroll
        for (unsigned j = 0; j < 16; ++j) { const unsigned c = xb_ld(&bar[XB_XCNT(j)]); sum += c; cnt += (c > 0u) ? 1u : 0u; mine = (j == x) ? c : mine; }
        if (sum == G) break;
        __builtin_amdgcn_s_sleep(1);
        if ((++sp & 255u) == 0u) { if (xb_ld(&bar[XB_TMO])) break; if (sp > XB_SPIN_CAP) { atomicAdd(&bar[XB_TMO], 1u); break; } }
    }
    nloc = mine > 0u ? mine : 1u; nx = cnt > 0u ? cnt : 1u;
}
__device__ __forceinline__ void xcd_barrier(const XcdBarrier& b) {
    asm volatile("s_waitcnt vmcnt(0)" ::: "memory");
    __syncthreads();
    if (threadIdx.x == 0) {
        unsigned* bar = b.bar;
        __builtin_amdgcn_s_waitcnt(0);
        unsigned nloc = b.st[0], nx = b.st[1];
        if (nloc == 0u) { xcd_barrier_complete(bar, b.x, nloc, nx); b.st[0] = nloc; b.st[1] = nx; }
        const unsigned old = xb_add(&bar[XB_XSUB(b.x)], 1u);
        const unsigned gen = old / nloc;
        if (old + 1u == (gen + 1u) * nloc) {
            __builtin_amdgcn_fence(__ATOMIC_RELEASE, "agent");
            asm volatile("s_waitcnt vmcnt(0)" ::: "memory");
            const unsigned og = xb_add(&bar[XB_TOP], 1u);
            const unsigned tg = og / nx;
            if (og + 1u == (tg + 1u) * nx) xb_add(&bar[XB_TOPGEN], 1u);
            else XB_SPIN(xb_ld(&bar[XB_TOPGEN]) == tg, bar);
            __builtin_amdgcn_fence(__ATOMIC_ACQUIRE, "agent");
            xb_add(&bar[XB_XGEN(b.x)], 1u);
            asm volatile("s_waitcnt vmcnt(0)" ::: "memory");
        } else {
            XB_SPIN(xb_ld(&bar[XB_XGEN(b.x)]) == gen, bar);
            __builtin_amdgcn_fence(__ATOMIC_ACQUIRE, "agent");
            asm volatile("s_waitcnt vmcnt(0)" ::: "memory");
        }
    }
    __syncthreads();
}

__global__ void __launch_bounds__(512, 2) hybrid_fwd(Params p, int ph_lo, int ph_hi) {
    __shared__ __attribute__((aligned(1024))) char smem[SMEM_BYTES];
    __shared__ uint4 xb_words;
    cg::grid_group grid = cg::this_grid();
    if (ph_lo < 0) grid.sync();
    if (threadIdx.x == 0) xb_words = make_uint4(0u, 0u, 0u, 0u);
    __syncthreads();
    const XcdBarrier xb = xcd_barrier_post((unsigned*)(p.ws + OFF_BAR), (volatile LDSP unsigned*)&xb_words);
    for (int ph = ph_lo; ph <= ph_hi; ++ph) {
        const int nb = onb(), bid = obid();
        if (ph == 0) phase_prepass(p, smem);
        else {
            const int layer = (ph - 1) / 7, s = (ph - 1) % 7;
            if (s == 0) phase_inproj(p, layer, smem);
            else if (s == 1) {
                for (int it = bid; it < 256 + 1024; it += nb) {
                    if (it < 256) attn_item(p, it * 8 + (otid() >> 6));
                    else if (it < 256 + 512) rec_pass1<64, true>(p, layer, it - 256, smem);
                    else rec_pass1<32, false>(p, layer, it - 768, smem);
                }
            } else if (s == 2) { for (int it = bid; it < 192; it += nb) rec_stepB(p, it); }
            else if (s == 3) {
                for (int wi = bid * 8 + (otid() >> 6); wi < 8192; wi += nb * 8) {
                    if (wi < 4096) rec_pass2<64, true>(p, layer, wi);
                    else rec_pass2<32, false>(p, layer, wi - 4096);
                }
            } else if (s == 4) phase_gates(p, layer, smem);
            else if (s == 5) phase_upmerge(p, layer, smem);
            else phase_outproj_ln(p, layer, smem);
        }
        if (ph < ph_hi && !(ph > 0 && (ph - 1) % 7 == 4)) xcd_barrier(xb);
    }
}

extern "C" void kernel_launch(void* const* d_in, const int* in_sizes, int n_in, void* d_out, int out_size, void* d_ws, size_t ws_size, hipStream_t stream) {
    (void)in_sizes; (void)n_in; (void)out_size;
    if (ws_size < WS_NEED) { fprintf(stderr, "workspace too small: %zu < %zu\n", ws_size, (size_t)WS_NEED); return; }
    static int grid_blocks = 0;
    if (!grid_blocks) {
        int dev = 0, cus = 0, per_cu = 0;
        (void)hipGetDevice(&dev);
        (void)hipDeviceGetAttribute(&cus, hipDeviceAttributeMultiprocessorCount, dev);
        (void)hipOccupancyMaxActiveBlocksPerMultiprocessor(&per_cu, hybrid_fwd, NTH, 0);
        if (per_cu > 1) per_cu = 1;
        if (per_cu < 1) per_cu = 1;
        grid_blocks = cus * per_cu;
        grid_blocks -= grid_blocks % 8;
    }
    Params p{};
    p.x = (const float*)d_in[0]; p.w_in = (const float*)d_in[1]; p.w2 = (const float*)d_in[2]; p.gb = (const float*)d_in[3];
    p.lbl = (const float*)d_in[4]; p.hg = (const float*)d_in[5]; p.gg = (const float*)d_in[6]; p.w_up = (const float*)d_in[7];
    p.w_out = (const float*)d_in[8]; p.ln_g = (const float*)d_in[9]; p.ln_b = (const float*)d_in[10];
    p.out = (float*)d_out; p.ws = (char*)d_ws;
    int lo = 0, hi = 14;
    void* args[] = {&p, &lo, &hi};
    (void)hipMemsetAsync((char*)d_ws + OFF_BAR, 0, XCD_BAR_WORDS * 4, stream);
    hipError_t e = hipLaunchCooperativeKernel((void*)hybrid_fwd, dim3(grid_blocks), dim3(NTH), args, 0, stream);
    if (e != hipSuccess) fprintf(stderr, "cooperative launch failed: %s (grid %d)\n", hipGetErrorString(e), grid_blocks);
}
```

```cpp
#include <hip/hip_runtime.h>
#include <hip/hip_cooperative_groups.h>
#include <cstdio>
#include <cstdint>
namespace cg = cooperative_groups;

typedef unsigned short bf16_t;
typedef short bf16x8 __attribute__((ext_vector_type(8)));
typedef float f32x4 __attribute__((ext_vector_type(4)));
typedef float f32x16 __attribute__((ext_vector_type(16)));
typedef unsigned u32x2 __attribute__((ext_vector_type(2)));
typedef unsigned u32x4 __attribute__((ext_vector_type(4)));

constexpr int T_ = 8192, M_ = 16384, D_ = 1024;
constexpr int NIN = 5904;
constexpr int NS1 = 2832;
constexpr int NP = 2560;
constexpr int NWG = 2944;
constexpr int NWT = NWG + 3072;
constexpr int NTH = 512;
constexpr int C_AQ = 0, C_AK = 256, C_AG = 512, C_HF = 768, C_HI = 1024, C_HQ = 1280, C_HG = 1536;
constexpr int C_CQ = 1792, C_CK = 1920, C_CV = 2048, C_CG = 2304, R_AV = 2560, C_CR = 2816;
constexpr float ALPHA = 1.41421356237309515f;
constexpr float EPS = 1e-5f;
constexpr float LOG2E = 1.44269504088896341f, LN2 = 0.69314718055994531f;

constexpr size_t SZ_WT_IN = (size_t)NWT * 1024 * 2, SZ_WT_UP = (size_t)3 * 1024 * 256 * 2, SZ_WT_OUT = (size_t)1024 * 1024 * 2;
constexpr size_t OFF_WT_IN = 0;
constexpr size_t OFF_WT_UP = OFF_WT_IN + 2 * SZ_WT_IN;
constexpr size_t OFF_WT_OUT = OFF_WT_UP + 2 * SZ_WT_UP;
constexpr size_t OFF_XB = OFF_WT_OUT + 2 * SZ_WT_OUT;
constexpr size_t OFF_PROJ = OFF_XB + (size_t)M_ * 1024 * 2;
constexpr size_t OFF_VT = OFF_PROJ + (size_t)M_ * 2816 * 2;
constexpr size_t OFF_GATES = OFF_PROJ;
constexpr size_t OFF_Y = OFF_VT + (size_t)8 * 64 * T_ * 2;
constexpr size_t OFF_SLOC_H = OFF_Y + (size_t)M_ * 768 * 2;
constexpr size_t OFF_SLOC_G = OFF_SLOC_H + (size_t)8 * 128 * 64 * 64 * 4;
constexpr size_t OFF_DEC_H = OFF_SLOC_G + (size_t)8 * 128 * 64 * 32 * 4;
constexpr size_t OFF_DEC_G = OFF_DEC_H + (size_t)8 * 128 * 64 * 4;
constexpr size_t OFF_SST_H = OFF_DEC_G + (size_t)8 * 128 * 32 * 4;
constexpr size_t OFF_SST_G = OFF_SST_H + (size_t)8 * 128 * 64 * 64 * 2;
constexpr size_t OFF_CR = OFF_SST_G + (size_t)8 * 128 * 64 * 32 * 2;
constexpr size_t OFF_BAR = OFF_CR + (size_t)M_ * 16 * 4;
constexpr size_t OFF_STATS = OFF_BAR + 16384;
constexpr size_t OFF_OI = OFF_STATS + (size_t)2 * 64 * 4 * 256 * 8;
constexpr size_t OFF_QH = OFF_OI + (size_t)M_ * 512 * 2;
constexpr size_t WS_NEED = OFF_QH + (size_t)M_ * 384 * 2;
constexpr size_t OFF_MERGED = OFF_SLOC_H;
static_assert(OFF_MERGED + (size_t)M_ * 1024 * 2 <= OFF_CR, "merged overlay");
static_assert(OFF_GATES + (size_t)M_ * 3072 * 2 <= OFF_Y, "gates overlay");

struct Params {
    const float* x; const float* w_in; const float* w2; const float* gb; const float* lbl; const float* hg; const float* gg;
    const float* w_up; const float* w_out; const float* ln_g; const float* ln_b;
    float* out; char* ws;
};

__device__ __forceinline__ float bf2f(bf16_t v) { return __uint_as_float(((unsigned)v) << 16); }
__device__ __forceinline__ float bflo(unsigned v) { return __uint_as_float(v << 16); }
__device__ __forceinline__ float bfhi(unsigned v) { return __uint_as_float(v & 0xffff0000u); }
typedef float f32x2 __attribute__((ext_vector_type(2)));
typedef __bf16 bf16x2v __attribute__((ext_vector_type(2)));
__device__ __forceinline__ unsigned pk_bf16(float lo, float hi) { f32x2 v = {lo, hi}; bf16x2v b = __builtin_convertvector(v, bf16x2v); return __builtin_bit_cast(unsigned, b); }
__device__ __forceinline__ bf16_t f2bf(float f) { return (bf16_t)(pk_bf16(f, 0.f) & 0xffffu); }
__device__ __forceinline__ float ex2(float x) { return __builtin_amdgcn_exp2f(x); }
__device__ __forceinline__ float lg2(float x) { return __builtin_amdgcn_logf(x); }
__device__ __forceinline__ float exn(float x) { return ex2(x * LOG2E); }
__device__ __forceinline__ float lgn(float x) { return lg2(x) * LN2; }
__device__ __forceinline__ float sigmoidf(float x) { return __builtin_amdgcn_rcpf(1.f + exn(-x)); }
__device__ __forceinline__ float siluf(float x) { return x * sigmoidf(x); }
__device__ __forceinline__ float logsigmoidf(float x) { return fminf(x, 0.f) - lgn(1.f + exn(-fabsf(x))); }

__device__ __forceinline__ int otid() { int t = threadIdx.x; asm volatile("" : "+v"(t)); return t; }
__device__ __forceinline__ int obid() { int t = blockIdx.x; asm volatile("" : "+s"(t)); return t; }
__device__ __forceinline__ int onb() { int t = gridDim.x; asm volatile("" : "+s"(t)); return t; }
constexpr int LROW = 72;
constexpr int SMEM_BYTES = 131072;
constexpr int REC_LDS = 55296;
#define LDSP __attribute__((address_space(3)))

__device__ __forceinline__ bool tile_order(int v, int nM, int nN, int& tm, int& tn) {
    const int nwg = nM * nN; if (v >= nwg) return false;
    const int q = nwg / 8, r = nwg % 8, xcd = v % 8, off = v / 8;
    const int wgid = (xcd < r ? xcd * (q + 1) : r * (q + 1) + (xcd - r) * q) + off;
    const int nig = 8 * nN, gid = wgid / nig, fm = gid * 8, gsz = (nM - fm) < 8 ? (nM - fm) : 8;
    tm = fm + ((wgid % nig) % gsz); tn = (wgid % nig) / gsz; return true;
}

__device__ __forceinline__ void stage_rc(int b, int& R, int& C) {
    const int st = b >> 10, sb = b & 1023, swz = sb ^ (((sb >> 9) & 1) << 5);
    R = st * 16 + swz / 64; C = (swz % 64) / 2;
}
template <int MT, int NT>
struct Gemm2P {
    static constexpr int TA = 32 * MT * 64, TB = 64 * NT * 64, GA = TA / 8192, GB = TB / 8192, STG = TA + TB, PAIR = 2 * STG;
    static_assert(2 * PAIR <= SMEM_BYTES && GA >= 1 && GB >= 1, "LDS");
    LDSP char* lds; int wid, aoff, boff, gp;
    unsigned offA[GA], offB[GB]; const char* Ab; const char* Bb; int rowsel;
    __device__ __forceinline__ void init(char* smem) {
        lds = (LDSP char*)smem; gp = 0;
        const int tid = otid(), lane = tid & 63, fr = lane & 15, fq = lane >> 4;
        wid = __builtin_amdgcn_readfirstlane(tid >> 6);
        const int wr = wid >> 2, wc = wid & 3;
        const int lo = ((fr * 64 + fq * 16) ^ ((fr >> 3) << 5));
        aoff = (wr * MT) * 1024 + lo; boff = TA + (wc * NT) * 1024 + lo;
        rowsel = lane;
    }
    __device__ __forceinline__ void set(const bf16_t* A, int lda, const bf16_t* B, int ldb) {
        Ab = (const char*)A; Bb = (const char*)B;
#pragma unroll
        for (int i = 0; i < GA; ++i) { int R, C; stage_rc(wid * 1024 + i * 8192 + rowsel * 16, R, C); offA[i] = (unsigned)(R * lda + C) * 2u; }
#pragma unroll
        for (int i = 0; i < GB; ++i) { int R, C; stage_rc(wid * 1024 + i * 8192 + rowsel * 16, R, C); offB[i] = (unsigned)(R * ldb + C) * 2u; }
    }
    __device__ __forceinline__ void stage_pair(int tp, int buf) {
#pragma unroll
        for (int h = 0; h < 2; ++h) {
#pragma unroll
            for (int i = 0; i < GA; ++i) __builtin_amdgcn_global_load_lds((const unsigned*)(Ab + offA[i] + (2 * tp + h) * 64), (LDSP unsigned*)(lds + buf * PAIR + h * STG + wid * 1024 + i * 8192), 16, 0, 0);
#pragma unroll
            for (int i = 0; i < GB; ++i) __builtin_amdgcn_global_load_lds((const unsigned*)(Bb + offB[i] + (2 * tp + h) * 64), (LDSP unsigned*)(lds + buf * PAIR + h * STG + TA + wid * 1024 + i * 8192), 16, 0, 0);
        }
    }
    __device__ __forceinline__ void prefetch() { stage_pair(0, gp & 1); }
    __device__ __forceinline__ void run(int ntp, f32x4 (&acc)[MT][NT]) {
        asm volatile("s_waitcnt vmcnt(0) lgkmcnt(0)" ::: "memory"); __builtin_amdgcn_s_barrier();
        const bool lower = wid >= 4;
        bf16x8 af[MT], bfr[NT];
#define G2_READ(off) do { \
            _Pragma("unroll") for (int m = 0; m < MT; ++m) af[m] = *(const LDSP bf16x8*)(lds + (off) + aoff + m * 1024); \
            _Pragma("unroll") for (int n = 0; n < NT; ++n) bfr[n] = *(const LDSP bf16x8*)(lds + (off) + boff + n * 1024); } while (0)
#define G2_MMA() do { \
            _Pragma("unroll") for (int m = 0; m < MT; ++m) _Pragma("unroll") for (int n = 0; n < NT; ++n) acc[m][n] = __builtin_amdgcn_mfma_f32_16x16x32_bf16(bfr[n], af[m], acc[m][n], 0, 0, 0); } while (0)
#define G2_SB() __builtin_amdgcn_sched_barrier(0)
#define G2_WAITBAR() do { asm volatile("s_waitcnt vmcnt(0) lgkmcnt(0)" ::: "memory"); __builtin_amdgcn_s_barrier(); } while (0)
        if (!lower) {
            for (int tp = 0; tp < ntp; ++tp) {
                const int cur = ((gp + tp) & 1) * PAIR;
                if (tp + 1 < ntp) stage_pair(tp + 1, (gp + tp + 1) & 1);
                G2_READ(cur); G2_SB(); G2_MMA(); G2_SB();
                G2_READ(cur + STG); G2_SB(); G2_MMA(); G2_SB();
                G2_WAITBAR();
            }
        } else {
            {
                const int cur = (gp & 1) * PAIR;
                if (1 < ntp) stage_pair(1, (gp + 1) & 1);
                G2_READ(cur); G2_SB(); G2_MMA(); G2_SB();
                G2_READ(cur + STG); G2_SB();
                G2_WAITBAR();
            }
            for (int tp = 1; tp < ntp; ++tp) {
                const int cur = ((gp + tp) & 1) * PAIR;
                if (tp + 1 < ntp) stage_pair(tp + 1, (gp + tp + 1) & 1);
                G2_SB(); G2_MMA(); G2_SB();
                G2_READ(cur); G2_SB(); G2_MMA(); G2_SB();
                G2_READ(cur + STG); G2_SB();
                G2_WAITBAR();
            }
            G2_MMA();
        }
#undef G2_READ
#undef G2_MMA
#undef G2_SB
#undef G2_WAITBAR
        gp += ntp;
    }
};
template <int MT, int NT>
__device__ __forceinline__ void zero_acc(f32x4 (&acc)[MT][NT]) {
#pragma unroll
    for (int m = 0; m < MT; ++m)
#pragma unroll
        for (int n = 0; n < NT; ++n) acc[m][n] = (f32x4){0.f, 0.f, 0.f, 0.f};
}

namespace pg8 {
#define PG8_LAS __attribute__((address_space(3)))
typedef unsigned short bf16_t;
typedef short bf16x8 __attribute__((ext_vector_type(8)));
typedef float f32x4 __attribute__((ext_vector_type(4)));
typedef unsigned u32x4 __attribute__((ext_vector_type(4)));
constexpr int BM = 256, BK = 64, HALF = 128, HTB = HALF * BK * 2  , STAGE_BYTES = 8 * HTB, NXCD = 8, WGM = 8;

__host__ __device__ __forceinline__ int lds_byte(int r, int c) { const int st = (r >> 4) * 2 + (c >> 5), rr = r & 15, cc = c & 31, ob = rr * 64 + cc * 2; return st * 1024 + (ob ^ (((ob >> 9) & 1) << 5)); }
__host__ __device__ __forceinline__ void stage_rc(int b, int& R, int& C) { const int st = b / 1024, sb = b % 1024, swz = sb ^ (((sb >> 9) & 1) << 5); R = (st >> 1) * 16 + swz / 64; C = (st & 1) * 32 + (swz % 64) / 2; }
__host__ __device__ __forceinline__ int perm32(int rho) { const int n = rho >> 4, i = rho & 15; return 8 * (i >> 2) + 4 * n + (i & 3); }

struct Unit { int pm, pn; };
struct Gemm { const bf16_t* A; const bf16_t* Bt; int M, N, K; int lda = 0; };

struct StaticOrder {
    int nM, nN, nwg, G, c;
    __host__ __device__ void init(int M, int N, int G_, int c_) { nM = M / BM; nN = N / BM; nwg = nM * nN; G = G_; c = c_; }
    __host__ __device__ bool next(int i, Unit& u) const {
        const long L = (long)i * G + c; if (L >= nwg) return false;
        int wgid = (int)L; { const int q = nwg / NXCD, r = nwg % NXCD, xcd = wgid % NXCD, off = wgid / NXCD; wgid = (xcd < r ? xcd * (q + 1) : r * (q + 1) + (xcd - r) * q) + off; }
        const int nig = WGM * nN, gid = wgid / nig, fm = gid * WGM, gsz = (nM - fm) < WGM ? (nM - fm) : WGM;
        u.pm = fm + ((wgid % nig) % gsz); u.pn = (wgid % nig) / gsz; return true;
    }
    __device__ __forceinline__ void a_ready(const Unit&) const {}
    __device__ __forceinline__ void done(const Unit&) const {}
    __device__ __forceinline__ size_t a_off(const Unit&) const { return 0; }
};

template <int ACT, bool VTP = false> struct EpiBf16S {
    static constexpr bool PERM = true, AFTER_DRAIN = false, KEEP_ACC = false;
    bf16_t* O; int ldc; int split_cols; size_t split_stride;
    __device__ __forceinline__ void operator()(const f32x4 (&acc)[2][2][4][2], const Unit& u, int wr, int wc, int fr, int fq) const {
        const int row0 = u.pm * BM + wr * 64 + fr; int colt = u.pn * BM; bf16_t* base = O;
        if (split_cols) { const int t = colt / split_cols; base += (size_t)t * split_stride; colt -= t * split_cols; }
        const int col0 = colt + wc * 32 + 8 * fq;
#pragma unroll
        for (int ai = 0; ai < 2; ++ai)
#pragma unroll
            for (int m = 0; m < 4; ++m) { bf16_t* rowp = base + (size_t)(row0 + ai * HALF + m * 16) * ldc + col0;
#pragma unroll
                for (int bj = 0; bj < 2; ++bj) { f32x4 v0 = acc[ai][bj][m][0], v1 = acc[ai][bj][m][1];
                    if (ACT == 2) { v0 = (f32x4){sigmoidf(v0[0]), sigmoidf(v0[1]), sigmoidf(v0[2]), sigmoidf(v0[3])}; v1 = (f32x4){sigmoidf(v1[0]), sigmoidf(v1[1]), sigmoidf(v1[2]), sigmoidf(v1[3])}; }
                    u32x4 w4; w4.x = pk_bf16(v0[0], v0[1]); w4.y = pk_bf16(v0[2], v0[3]); w4.z = pk_bf16(v1[0], v1[1]); w4.w = pk_bf16(v1[2], v1[3]);
                    if (VTP) { bf16_t* gp = rowp - 8 * fq + bj * HALF; u32x2 a, b; a.x = w4.x; a.y = w4.y; b.x = w4.z; b.y = w4.w; *(u32x2*)(gp + 4 * fq) = a; *(u32x2*)(gp + 16 + 4 * fq) = b; }
                    else *(u32x4*)(rowp + bj * HALF) = w4; } }
    }
};

template <class Epi, class Sched, bool ALIGN_EPI = false, bool SP2 = false>
__device__ __forceinline__ void gemm_phase(PG8_LAS unsigned char* lds, const Gemm g, const Sched& S, const Epi& E) {
    const int tid = otid(), wid = __builtin_amdgcn_readfirstlane(tid >> 6), lane = tid & 63, wr = wid >> 2, wc = wid & 3, fr = lane & 15, fq = lane >> 4;
    const int K = g.K, nt = K / BK, lda = g.lda ? g.lda : g.K;
    unsigned voffA[2], voffB[2];
#pragma unroll
    for (int i = 0; i < 2; ++i) { int R, C; stage_rc(tid * 16 + i * 8192, R, C); const int Rb = Epi::PERM ? ((R & ~31) + perm32(R & 31)) : R;
        voffA[i] = (unsigned)(R * lda + C) * 2u; voffB[i] = (unsigned)(Rb * K + C) * 2u; }
    const size_t kstep = (size_t)(BK * 2);
    const size_t hstep = (size_t)HALF * K * 2;
    const size_t tstep = 2 * hstep;
    const size_t hstepA = (size_t)HALF * lda * 2, tstepA = 2 * hstepA;
    const unsigned ldsw = (unsigned)wid * 1024u;
    const int aoff = lds_byte(wr * 64 + fr, fq * 8), boff = lds_byte(wc * 32 + fr, fq * 8);
#define PG8_SA(b, h) (((b) * 2 + (h)) * HTB)
#define PG8_SB(b, h) ((4 + (b) * 2 + (h)) * HTB)
#define PG8_STAGE(bufoff, gbase, voff) do { _Pragma("unroll") for (int _i = 0; _i < 2; ++_i) \
        __builtin_amdgcn_global_load_lds((const unsigned*)((const char*)(gbase) + (voff)[_i]), (PG8_LAS unsigned*)(lds + (bufoff) + ldsw + _i * 8192), 16, 0, 0); } while (0)
#define PG8_LDA(dst, b, h) do { _Pragma("unroll") for (int m = 0; m < 4; ++m) _Pragma("unroll") for (int k = 0; k < 2; ++k) dst[m][k] = *(const PG8_LAS bf16x8*)(lds + PG8_SA(b, h) + aoff + m * 2048 + k * 1024); } while (0)
#define PG8_LDB(dst, b, h) do { _Pragma("unroll") for (int n = 0; n < 2; ++n) _Pragma("unroll") for (int k = 0; k < 2; ++k) dst[n][k] = *(const PG8_LAS bf16x8*)(lds + PG8_SB(b, h) + boff + n * 2048 + k * 1024); } while (0)
#define PG8_MMA(ai, bj, At, Bt) do { __builtin_amdgcn_s_setprio(1); _Pragma("unroll") for (int m = 0; m < 4; ++m) _Pragma("unroll") for (int n = 0; n < 2; ++n) _Pragma("unroll") for (int k = 0; k < 2; ++k) \
        acc[ai][bj][m][n] = __builtin_amdgcn_mfma_f32_16x16x32_bf16(Bt[n][k], At[m][k], acc[ai][bj][m][n], 0, 0, 0); __builtin_amdgcn_s_setprio(0); } while (0)
#define PG8_WAIT_V(n) asm volatile("s_waitcnt vmcnt(" #n ")" ::: "memory")
#define PG8_WAIT_L(n) asm volatile("s_waitcnt lgkmcnt(" #n ")" ::: "memory")
#define PG8_BAR __builtin_amdgcn_s_barrier()
#define PG8_SCHED __builtin_amdgcn_sched_barrier(0)
    Unit cur, nxt; int ui = 0;
    if (!S.next(0, cur)) return;
    f32x4 acc[2][2][4][2];
#pragma unroll
    for (int a = 0; a < 2; ++a)
#pragma unroll
        for (int b = 0; b < 2; ++b)
#pragma unroll
            for (int m = 0; m < 4; ++m)
#pragma unroll
                for (int n = 0; n < 2; ++n) acc[a][b][m][n] = (f32x4){0.f, 0.f, 0.f, 0.f};
    bf16x8 At[4][2], B0[2][2], B1[2][2];
    const char* cA = (const char*)g.A + (size_t)cur.pm * tstepA + S.a_off(cur); const char* cB = (const char*)g.Bt + (size_t)cur.pn * tstep;
    S.a_ready(cur);
    if constexpr (SP2) {
        PG8_STAGE(PG8_SB(0, 0), cB, voffB); PG8_STAGE(PG8_SB(0, 1), cB + hstep, voffB); PG8_STAGE(PG8_SA(0, 0), cA, voffA); PG8_STAGE(PG8_SA(0, 1), cA + hstepA, voffA);
        if (wr == 1) PG8_BAR;
        PG8_WAIT_V(2); PG8_BAR;
        PG8_STAGE(PG8_SB(1, 0), cB + kstep, voffB); PG8_STAGE(PG8_SA(1, 0), cA + kstep, voffA); PG8_STAGE(PG8_SB(1, 1), cB + hstep + kstep, voffB);
        PG8_WAIT_V(6); PG8_BAR;
    } else {
        PG8_STAGE(PG8_SB(0, 0), cB, voffB); PG8_STAGE(PG8_SA(0, 0), cA, voffA); PG8_STAGE(PG8_SB(0, 1), cB + hstep, voffB); PG8_STAGE(PG8_SA(0, 1), cA + hstepA, voffA);
        if (wr == 1) PG8_BAR;
        PG8_WAIT_V(4); PG8_BAR;
        PG8_STAGE(PG8_SB(1, 0), cB + kstep, voffB); PG8_STAGE(PG8_SA(1, 0), cA + kstep, voffA); PG8_STAGE(PG8_SB(1, 1), cB + hstep + kstep, voffB);
        PG8_WAIT_V(6); PG8_BAR;
    }
    for (;;) {
        const bool has_next = S.next(ui + 1, nxt);
        const char* nA = has_next ? (const char*)g.A + (size_t)nxt.pm * tstepA + S.a_off(nxt) : cA; const char* nB = has_next ? (const char*)g.Bt + (size_t)nxt.pn * tstep : cB;
        for (int t = 0; t < nt; t += 2) {
            const bool last = (t == nt - 2);
            const char* a1 = cA + (size_t)(t + 1) * kstep;
            const char* a2 = last ? nA : cA + (size_t)(t + 2) * kstep; const char* b2 = last ? nB : cB + (size_t)(t + 2) * kstep;
            const char* a3 = a2 + kstep; const char* b3 = b2 + kstep;
            if (last && has_next) S.a_ready(nxt);
            if constexpr (SP2) {
            PG8_LDB(B0, 0, 0); PG8_LDB(B1, 0, 1); PG8_SCHED; PG8_LDA(At, 0, 0); PG8_STAGE(PG8_SA(1, 1), a1 + hstepA, voffA);
            PG8_WAIT_V(8); PG8_WAIT_L(0); PG8_BAR; PG8_MMA(0, 0, At, B0); PG8_MMA(0, 1, At, B1); PG8_BAR; PG8_SCHED;
            PG8_LDA(At, 0, 1); PG8_STAGE(PG8_SB(0, 0), b2, voffB); PG8_STAGE(PG8_SB(0, 1), b2 + hstep, voffB); PG8_STAGE(PG8_SA(0, 0), a2, voffA);
            PG8_WAIT_V(8); PG8_WAIT_L(0); PG8_BAR; PG8_MMA(1, 0, At, B0); PG8_MMA(1, 1, At, B1); PG8_BAR; PG8_SCHED;
            PG8_LDB(B0, 1, 0); PG8_LDB(B1, 1, 1); PG8_SCHED; PG8_LDA(At, 1, 0); PG8_STAGE(PG8_SA(0, 1), a2 + hstepA, voffA);
            PG8_WAIT_V(8); PG8_WAIT_L(0); PG8_BAR; PG8_MMA(0, 0, At, B0); PG8_MMA(0, 1, At, B1); PG8_BAR; PG8_SCHED;
            PG8_LDA(At, 1, 1); PG8_STAGE(PG8_SB(1, 0), b3, voffB); PG8_STAGE(PG8_SB(1, 1), b3 + hstep, voffB); PG8_STAGE(PG8_SA(1, 0), a3, voffA);
            PG8_WAIT_V(8); PG8_WAIT_L(0); PG8_BAR; PG8_MMA(1, 0, At, B0); PG8_MMA(1, 1, At, B1); PG8_BAR; PG8_SCHED;
            } else {
            PG8_LDB(B0, 0, 0); PG8_SCHED; PG8_LDA(At, 0, 0); PG8_STAGE(PG8_SA(1, 1), a1 + hstepA, voffA);
            PG8_WAIT_L(8); PG8_BAR; PG8_WAIT_L(0); PG8_MMA(0, 0, At, B0); PG8_BAR; PG8_SCHED;
            PG8_LDB(B1, 0, 1); PG8_STAGE(PG8_SB(0, 0), b2, voffB);
            PG8_BAR; PG8_WAIT_L(0); PG8_MMA(0, 1, At, B1); PG8_BAR;
            PG8_LDA(At, 0, 1); PG8_STAGE(PG8_SA(0, 0), a2, voffA);
            PG8_BAR; PG8_WAIT_L(0); PG8_MMA(1, 0, At, B0); PG8_BAR; PG8_SCHED;
            PG8_STAGE(PG8_SB(0, 1), b2 + hstep, voffB);
            PG8_WAIT_V(6); PG8_BAR; PG8_MMA(1, 1, At, B1); PG8_BAR;
            PG8_LDB(B0, 1, 0); PG8_SCHED; PG8_LDA(At, 1, 0); PG8_STAGE(PG8_SA(0, 1), a2 + hstepA, voffA);
            PG8_WAIT_L(8); PG8_BAR; PG8_WAIT_L(0); PG8_MMA(0, 0, At, B0); PG8_BAR; PG8_SCHED;
            PG8_LDB(B1, 1, 1); PG8_STAGE(PG8_SB(1, 0), b3, voffB);
            PG8_BAR; PG8_WAIT_L(0); PG8_MMA(0, 1, At, B1); PG8_BAR;
            PG8_LDA(At, 1, 1); PG8_STAGE(PG8_SA(1, 0), a3, voffA);
            PG8_BAR; PG8_WAIT_L(0); PG8_MMA(1, 0, At, B0); PG8_BAR; PG8_SCHED;
            PG8_STAGE(PG8_SB(1, 1), b3 + hstep, voffB);
            PG8_WAIT_V(6); PG8_BAR; PG8_MMA(1, 1, At, B1); PG8_BAR;
            }
        }
        if constexpr (ALIGN_EPI) { if (wr == 0) PG8_BAR; }
        if constexpr (!Epi::AFTER_DRAIN) { E(acc, cur, wr, wc, fr, fq); S.done(cur); }
        if (!has_next) break;
        if constexpr (!Epi::KEEP_ACC) {
#pragma unroll
        for (int a = 0; a < 2; ++a)
#pragma unroll
            for (int b = 0; b < 2; ++b)
#pragma unroll
                for (int m = 0; m < 4; ++m)
#pragma unroll
                    for (int n = 0; n < 2; ++n) acc[a][b][m][n] = (f32x4){0.f, 0.f, 0.f, 0.f};
        }
        cur = nxt; cA = nA; cB = nB; ++ui;
        if constexpr (ALIGN_EPI) { if (wr == 1) PG8_BAR; }
    }
    PG8_WAIT_V(0);
    if constexpr (!ALIGN_EPI) { if (wr == 0) PG8_BAR; }
    PG8_BAR;
    if constexpr (Epi::AFTER_DRAIN) { E.fused(acc, cur, wr, wc, fr, fq, lds, wid, lane); S.done(cur); }
#undef PG8_SA
#undef PG8_SB
#undef PG8_STAGE
#undef PG8_LDA
#undef PG8_LDB
#undef PG8_MMA
#undef PG8_WAIT_V
#undef PG8_WAIT_L
#undef PG8_BAR
#undef PG8_SCHED
}
}

__device__ __forceinline__ void transpose_tile(const float* __restrict__ src, int lds_, int C, int k0, int n0, bf16_t* __restrict__ dst, int ldd, int split, int shift, float* tile) {
    const int tid = otid();
    __syncthreads();
    {
        f32x4 v[8];
#pragma unroll
        for (int j = 0; j < 8; ++j) { const int idx = tid + 512 * j, k = idx >> 6, n = n0 + 4 * (idx & 63);
            v[j] = (n < C) ? *(const f32x4*)(src + (size_t)(k0 + k) * lds_ + n) : (f32x4){0.f, 0.f, 0.f, 0.f}; }
#pragma unroll
        for (int j = 0; j < 8; ++j) { const int idx = tid + 512 * j, k = idx >> 6, nl = 4 * (idx & 63);
            tile[k * 257 + nl] = v[j][0]; tile[k * 257 + nl + 1] = v[j][1]; tile[k * 257 + nl + 2] = v[j][2]; tile[k * 257 + nl + 3] = v[j][3]; }
    }
    __syncthreads();
    {
#pragma unroll
        for (int it2 = 0; it2 < 4; ++it2) {
            const int q = it2 * 512 + tid, ko = q & 7, nl = q >> 3, n = n0 + nl;
            if (n < C) {
                const int dn = split == 1 ? (n < 512 ? n : n < 768 ? n + 2048 : n < 2816 ? n - 256 : n < NS1 ? n : n + (NWG - NS1)) : n;
                u32x4 o;
                o.x = pk_bf16(tile[(8 * ko + 0) * 257 + nl], tile[(8 * ko + 1) * 257 + nl]);
                o.y = pk_bf16(tile[(8 * ko + 2) * 257 + nl], tile[(8 * ko + 3) * 257 + nl]);
                o.z = pk_bf16(tile[(8 * ko + 4) * 257 + nl], tile[(8 * ko + 5) * 257 + nl]);
                o.w = pk_bf16(tile[(8 * ko + 6) * 257 + nl], tile[(8 * ko + 7) * 257 + nl]);
                *(u32x4*)(dst + (size_t)dn * ldd + k0 + 8 * ko) = o;
            }
        }
    }
}

__device__ __forceinline__ void phase_prepass(const Params& p, char* smem) {
    float* tile = (float*)smem;
    const int nb = onb(), bid = obid(), tid = otid();
    constexpr int T_IN = 16 * 24, T_UP = 3 * 4 * 4, T_OUT = 16 * 4, T_L = T_IN + T_UP + T_OUT;
    for (int v = bid; v < 2 * T_L; v += nb) {
        const int l = v / T_L; int t = v % T_L;
        if (t < T_IN) {
            const int kt = t % 16, nt = t / 16;
            transpose_tile(p.w_in + (size_t)l * 1024 * NIN, NIN, NIN, kt * 64, nt * 256, (bf16_t*)(p.ws + OFF_WT_IN + l * SZ_WT_IN), 1024, 1, 0, tile);
        } else if (t < T_IN + T_UP) {
            t -= T_IN; const int br = t / 16, r = t % 16, kt = r % 4, nt = r / 4;
            transpose_tile(p.w_up + ((size_t)l * 3 + br) * 256 * 1024, 1024, 1024, kt * 64, nt * 256, (bf16_t*)(p.ws + OFF_WT_UP + l * SZ_WT_UP) + (size_t)br * 1024 * 256, 256, 1 << 30, 0, tile);
        } else {
            t -= T_IN + T_UP; const int kt = t % 16, nt = t / 16;
            transpose_tile(p.w_out + (size_t)l * 1024 * 1024, 1024, 1024, kt * 64, nt * 256, (bf16_t*)(p.ws + OFF_WT_OUT + l * SZ_WT_OUT), 1024, 1 << 30, 0, tile);
        }
    }
    {
        const f32x4* xs = (const f32x4*)p.x; u32x2* xd = (u32x2*)(p.ws + OFF_XB);
        const int stride = nb * NTH;
        int i = bid * NTH + tid;
        for (; i + 3 * stride < M_ * 256; i += 4 * stride) {
            f32x4 v[4];
#pragma unroll
            for (int j = 0; j < 4; ++j) v[j] = xs[i + j * stride];
#pragma unroll
            for (int j = 0; j < 4; ++j) { u32x2 o; o.x = pk_bf16(v[j][0], v[j][1]); o.y = pk_bf16(v[j][2], v[j][3]); xd[i + j * stride] = o; }
        }
        for (; i < M_ * 256; i += stride) { const f32x4 v = xs[i]; u32x2 o; o.x = pk_bf16(v[0], v[1]); o.y = pk_bf16(v[2], v[3]); xd[i] = o; }
    }
}

__device__ __forceinline__ void phase_inproj(const Params& p, int layer, char* smem) {
    const bf16_t* xb = (const bf16_t*)(p.ws + OFF_XB);
    const bf16_t* wt = (const bf16_t*)(p.ws + OFF_WT_IN + layer * SZ_WT_IN);
    bf16_t* proj = (bf16_t*)(p.ws + OFF_PROJ);
    bf16_t* vt = (bf16_t*)(p.ws + OFF_VT);
    const int tid = otid(), lane = tid & 63, w = tid >> 6, fr = lane & 15, fq = lane >> 4;
    {
        pg8::Gemm g; g.A = xb; g.Bt = wt; g.M = M_; g.N = NP; g.K = 1024;
        pg8::StaticOrder S; S.init(M_, NP, onb(), obid());
        pg8::EpiBf16S<0> E; E.O = proj; E.ldc = NP; E.split_cols = 0; E.split_stride = 0;
        __syncthreads();
        pg8::gemm_phase<pg8::EpiBf16S<0>, pg8::StaticOrder, true, true>((PG8_LAS unsigned char*)smem, g, S, E);
    }
    {
        pg8::Gemm g; g.A = wt + (size_t)R_AV * 1024; g.Bt = xb; g.M = 256; g.N = M_; g.K = 1024;
        const int first = (M_ / 256) * (NP / 256) % onb();
        pg8::StaticOrder S; S.init(256, M_, onb(), (obid() + onb() - first) % onb());
        pg8::EpiBf16S<0, true> E; E.O = vt; E.ldc = T_; E.split_cols = T_; E.split_stride = (size_t)256 * T_;
        __syncthreads();
        pg8::gemm_phase<pg8::EpiBf16S<0, true>, pg8::StaticOrder, true, true>((PG8_LAS unsigned char*)smem, g, S, E);
    }
    {
        const int start = (640 + 64) % onb();
        const int nidle = onb() - start, r = (obid() + onb() - start) % onb();
        float* cr = (float*)(p.ws + OFF_CR);
        if (r < nidle)
        for (int g16 = r * 8 + w; g16 < M_ / 16; g16 += nidle * 8) {
            const bf16_t* ap = xb + (size_t)(g16 * 16 + fr) * 1024 + fq * 8;
            const bf16_t* bp = wt + (size_t)(C_CR + fr) * 1024 + fq * 8;
            f32x4 a4 = (f32x4){0.f, 0.f, 0.f, 0.f};
#pragma unroll 8
            for (int kk = 0; kk < 32; ++kk) a4 = __builtin_amdgcn_mfma_f32_16x16x32_bf16(*(const bf16x8*)(bp + kk * 32), *(const bf16x8*)(ap + kk * 32), a4, 0, 0, 0);
            *(f32x4*)(cr + (size_t)(g16 * 16 + fr) * 16 + 4 * fq) = a4;
        }
    }
}

__device__ __forceinline__ void attn_item(const Params& p, int item) {
    const bf16_t* proj = (const bf16_t*)(p.ws + OFF_PROJ);
    const bf16_t* vt = (const bf16_t*)(p.ws + OFF_VT);
    bf16_t* Y = (bf16_t*)(p.ws + OFF_Y);
    const int lane = otid() & 63, r = lane & 31, g = lane >> 5;
    const int qb = item & 255, bh = item >> 8, b = bh >> 2, h = bh & 3, t0 = qb * 32;
    const bf16_t* qrow = proj + (size_t)(b * T_ + t0 + r) * NP + C_AQ + h * 64 + 8 * g;
    bf16x8 qf[4];
#pragma unroll
    for (int kk = 0; kk < 4; ++kk) qf[kk] = *(const bf16x8*)(qrow + 16 * kk);
    f32x16 o0, o1;
#pragma unroll
    for (int i = 0; i < 16; ++i) { o0[i] = 0.f; o1[i] = 0.f; }
    float R = 0.f;
    const bf16_t* kbase = proj + (size_t)(b * T_) * NP + C_AK + h * 64 + 8 * g;
    const bf16_t* vtb = vt + (size_t)(bh * 64) * T_;
    const float CS = 0.125f * LOG2E;
#define ATT_LOAD(KF, V0, V1, JB) do { const int s0_ = (JB) * 32; \
        _Pragma("unroll") for (int kk = 0; kk < 4; ++kk) KF[kk] = *(const bf16x8*)(kbase + (size_t)(s0_ + r) * NP + 16 * kk); \
        _Pragma("unroll") for (int dt = 0; dt < 2; ++dt) { const bf16_t* vp = vtb + (size_t)(32 * dt + r) * T_ + s0_ + 16 * g; const u32x4 lo_ = *(const u32x4*)vp, hi_ = *(const u32x4*)(vp + 8); \
            V0[0][dt].x = lo_.x; V0[0][dt].y = lo_.y; V1[0][dt].x = lo_.z; V1[0][dt].y = lo_.w; V0[1][dt].x = hi_.x; V0[1][dt].y = hi_.y; V1[1][dt].x = hi_.z; V1[1][dt].y = hi_.w; } } while (0)
    bf16x8 kf[4]; u32x2 v00[2][2], v01[2][2];
    ATT_LOAD(kf, v00, v01, qb);
    for (int jb = qb; ; --jb) {
        bf16x8 kfn[4]; u32x2 v00n[2][2], v01n[2][2];
        if (jb > 0) ATT_LOAD(kfn, v00n, v01n, jb - 1);
        else {
#pragma unroll
            for (int kk = 0; kk < 4; ++kk) kfn[kk] = kf[kk];
#pragma unroll
            for (int ks = 0; ks < 2; ++ks)
#pragma unroll
                for (int dt = 0; dt < 2; ++dt) { v00n[ks][dt] = v00[ks][dt]; v01n[ks][dt] = v01[ks][dt]; }
        }
        f32x16 z;
#pragma unroll
        for (int i = 0; i < 16; ++i) z[i] = 0.f;
#pragma unroll
        for (int kk = 0; kk < 4; ++kk) z = __builtin_amdgcn_mfma_f32_32x32x16_bf16(kf[kk], qf[kk], z, 0, 0, 0);
        float sp[16], lw[16];
        const bool diag = (jb == qb);
#pragma unroll
        for (int i = 0; i < 16; ++i) {
            const float zs = fminf(z[i] * CS, 60.f);
            const float e = ex2(zs);
            float s = lg2(1.f + e);
            lw[i] = zs - s;
            if (diag) { const int sl = 8 * (i >> 2) + 4 * g + (i & 3); if (sl >= r) { s = 0.f; lw[i] = -1e30f; } }
            sp[i] = s;
        }
        float G[4], O[4];
#pragma unroll
        for (int a = 0; a < 4; ++a) { G[a] = (sp[4 * a] + sp[4 * a + 1]) + (sp[4 * a + 2] + sp[4 * a + 3]); O[a] = __shfl_xor(G[a], 32); }
        float Saf[4];
        Saf[3] = 0.f; Saf[2] = G[3] + O[3]; Saf[1] = Saf[2] + G[2] + O[2]; Saf[0] = Saf[1] + G[1] + O[1];
        const float total = Saf[0] + G[0] + O[0];
        float wgt[16];
#pragma unroll
        for (int a = 0; a < 4; ++a) {
            float tail = Saf[a] + (g == 0 ? O[a] : 0.f) + R;
#pragma unroll
            for (int c = 3; c >= 0; --c) { wgt[4 * a + c] = ex2(lw[4 * a + c] - tail); tail += sp[4 * a + c]; }
        }
        R += total;
#pragma unroll
        for (int ks = 0; ks < 2; ++ks) {
            union { bf16x8 v; unsigned u[4]; } pf;
#pragma unroll
            for (int j = 0; j < 4; ++j) pf.u[j] = pk_bf16(wgt[8 * ks + 2 * j], wgt[8 * ks + 2 * j + 1]);
            union { bf16x8 v; unsigned u[4]; } va, vb;
            va.u[0] = v00[ks][0].x; va.u[1] = v00[ks][0].y; va.u[2] = v01[ks][0].x; va.u[3] = v01[ks][0].y;
            vb.u[0] = v00[ks][1].x; vb.u[1] = v00[ks][1].y; vb.u[2] = v01[ks][1].x; vb.u[3] = v01[ks][1].y;
            o0 = __builtin_amdgcn_mfma_f32_32x32x16_bf16(va.v, pf.v, o0, 0, 0, 0);
            o1 = __builtin_amdgcn_mfma_f32_32x32x16_bf16(vb.v, pf.v, o1, 0, 0, 0);
        }
        if (jb == 0 || __all(R > 151.f)) break;
#pragma unroll
        for (int kk = 0; kk < 4; ++kk) kf[kk] = kfn[kk];
#pragma unroll
        for (int ks = 0; ks < 2; ++ks)
#pragma unroll
            for (int dt = 0; dt < 2; ++dt) { v00[ks][dt] = v00n[ks][dt]; v01[ks][dt] = v01n[ks][dt]; }
    }
#undef ATT_LOAD
    const size_t tok = (size_t)(b * T_ + t0 + r);
    u32x2 agv[2][4];
#pragma unroll
    for (int dt = 0; dt < 2; ++dt)
#pragma unroll
        for (int a = 0; a < 4; ++a) agv[dt][a] = *(const u32x2*)(proj + tok * NP + C_AG + h * 64 + 32 * dt + 8 * a + 4 * g);
#pragma unroll
    for (int dt = 0; dt < 2; ++dt)
#pragma unroll
        for (int a = 0; a < 4; ++a) {
            const int d = 32 * dt + 8 * a + 4 * g;
            const u32x2 gv = agv[dt][a];
            const float o_0 = dt ? o1[4 * a + 0] : o0[4 * a + 0], o_1 = dt ? o1[4 * a + 1] : o0[4 * a + 1], o_2 = dt ? o1[4 * a + 2] : o0[4 * a + 2], o_3 = dt ? o1[4 * a + 3] : o0[4 * a + 3];
            u32x2 ov; ov.x = pk_bf16(o_0 * siluf(bflo(gv.x)), o_1 * siluf(bfhi(gv.x))); ov.y = pk_bf16(o_2 * siluf(bflo(gv.y)), o_3 * siluf(bfhi(gv.y)));
            *(u32x2*)(Y + tok * 768 + h * 64 + d) = ov;
        }
}

template <int DK, bool HG>
__device__ __forceinline__ void rec_prologue(const Params& p, int layer, int b, int h, int c, char* smem) {
    float* cumS = (float*)smem; float* keyS = (float*)(smem + 17408); bf16_t* vT = (bf16_t*)(smem + 34816); float* part = (float*)(smem + 53248);
    const bf16_t* proj = (const bf16_t*)(p.ws + OFF_PROJ);
    const int tid = otid() & 255;
    constexpr int NG = 256 / DK, TPG = 64 / NG;
    const int k = tid % DK, grp = tid / DK;
    const size_t tokb = (size_t)b * T_ + c * 64;
    const int sV = tid >> 2, vcV = (tid & 3) * 16;
    const bf16_t* vpV = proj + (tokb + sV) * NP + (HG ? C_HI : C_CV) + h * 64 + vcV;
    const u32x4 a0V = *(const u32x4*)vpV, a1V = *(const u32x4*)(vpV + 8);
    bf16_t zr[TPG]; f32x4 crv[HG ? 1 : TPG][4];
    if (HG) {
#pragma unroll
        for (int i = 0; i < TPG; ++i) zr[i] = proj[(tokb + grp * TPG + i) * NP + C_HF + h * 64 + k];
    } else {
#pragma unroll
        for (int i = 0; i < TPG; ++i) {
            const f32x4* crp = (const f32x4*)((const float*)(p.ws + OFF_CR) + (tokb + grp * TPG + i) * 16);
            crv[i][0] = crp[0]; crv[i][1] = crp[1]; crv[i][2] = crp[2]; crv[i][3] = crp[3];
            zr[i] = proj[(tokb + grp * TPG + i) * NP + C_CK + h * 32 + k];
        }
    }
    __syncthreads();
    float run = 0.f;
    if (HG) {
        float lbv = 0.f;
        if (layer > 0) { float mx = -1e30f; for (int i = 0; i < 2; ++i) mx = fmaxf(mx, p.lbl[i * 256 + h * 64 + k]); float den = 0.f, num = 0.f;
            for (int i = 0; i < 2; ++i) { const float e = exn(p.lbl[i * 256 + h * 64 + k] - mx); den += e; if (i >= 1 && i <= layer) num += e; } lbv = num / den; }
#pragma unroll
        for (int i = 0; i < TPG; ++i) {
            const int s = grp * TPG + i;
            const float zf = bf2f(zr[i]);
            const float lf = logsigmoidf(zf) + lgn(1.f + lbv * exn(fminf(-zf, 60.f)));
            const float key = (1.f - lbv) * sigmoidf(-zf);
            run += lf; cumS[s * (DK + 1) + k] = run; keyS[s * (DK + 1) + k] = key;
        }
    } else {
        float w2r[16];
#pragma unroll
        for (int r = 0; r < 16; ++r) w2r[r] = p.w2[((size_t)layer * 16 + r) * 128 + h * 32 + k];
        const float bias = p.gb[layer * 128 + h * 32 + k];
#pragma unroll
        for (int i = 0; i < TPG; ++i) {
            const int s = grp * TPG + i;
            const f32x4 c0 = crv[HG ? 0 : i][0], c1 = crv[HG ? 0 : i][1], c2 = crv[HG ? 0 : i][2], c3 = crv[HG ? 0 : i][3];
            float gp = bias;
            gp += c0[0] * w2r[0] + c0[1] * w2r[1] + c0[2] * w2r[2] + c0[3] * w2r[3] + c1[0] * w2r[4] + c1[1] * w2r[5] + c1[2] * w2r[6] + c1[3] * w2r[7];
            gp += c2[0] * w2r[8] + c2[1] * w2r[9] + c2[2] * w2r[10] + c2[3] * w2r[11] + c3[0] * w2r[12] + c3[1] * w2r[13] + c3[2] * w2r[14] + c3[3] * w2r[15];
            const float lf = logsigmoidf(gp) * (1.f / 16.f);
            const float key = bf2f(zr[i]);
            run += lf; cumS[s * (DK + 1) + k] = run; keyS[s * (DK + 1) + k] = key;
        }
    }
    part[grp * 64 + k] = run;
    {
        const int s = sV, vc = vcV; const u32x4 a0 = a0V, a1 = a1V;
        const unsigned uu[8] = {a0.x, a0.y, a0.z, a0.w, a1.x, a1.y, a1.z, a1.w};
#pragma unroll
        for (int e = 0; e < 8; ++e) { vT[(vc + 2 * e) * LROW + s] = (bf16_t)(uu[e] & 0xffffu); vT[(vc + 2 * e + 1) * LROW + s] = (bf16_t)(uu[e] >> 16); }
    }
    __syncthreads();
    float pre = 0.f;
    for (int g2 = 0; g2 < grp; ++g2) pre += part[g2 * 64 + k];
#pragma unroll 4
    for (int i = 0; i < TPG; ++i) cumS[(grp * TPG + i) * (DK + 1) + k] += pre;
    __syncthreads();
}

__device__ __forceinline__ void rec_stepB(const Params& p, int item) {
    if (otid() >= 256) return;
    const int eg0 = item * 256 + otid();
    const bool hgr = eg0 < 32768;
    const int eg = hgr ? eg0 : eg0 - 32768;
    const int DK = hgr ? 64 : 32;
    const int bh = eg / (64 * DK), e = eg % (64 * DK), k = e % DK;
    const float* sloc = (const float*)(p.ws + (hgr ? OFF_SLOC_H : OFF_SLOC_G)) + (size_t)bh * 128 * 64 * DK + e;
    const float* dec = (const float*)(p.ws + (hgr ? OFF_DEC_H : OFF_DEC_G)) + (size_t)bh * 128 * DK + k;
    bf16_t* sst = (bf16_t*)(p.ws + (hgr ? OFF_SST_H : OFF_SST_G)) + (size_t)bh * 128 * 64 * DK + e;
    const int cs = 64 * DK;
    float S = 0.f;
    for (int c0 = 0; c0 < 128; c0 += 32) {
        float sl[32], dc[32];
#pragma unroll
        for (int j = 0; j < 32; ++j) { sl[j] = sloc[(size_t)(c0 + j) * cs]; dc[j] = dec[(c0 + j) * DK]; }
#pragma unroll
        for (int j = 0; j < 32; ++j) { sst[(size_t)(c0 + j) * cs] = f2bf(S); S = dc[j] * S + sl[j]; }
    }
}

template <int DK, bool HG>
__device__ __forceinline__ void rec_pass1(const Params& p, int layer, int pair, char* smem) {
    const int item = 2 * pair + (otid() >> 8); smem += (otid() >> 8) * REC_LDS;
    const int c = item & 127, bh = item >> 7, b = bh >> 2, h = bh & 3;
    const bf16_t* proj = (const bf16_t*)(p.ws + OFF_PROJ);
    const int tid = otid() & 255, lane = tid & 63, w = (otid() >> 8) ? 3 - (tid >> 6) : (tid >> 6), fr = lane & 15, fq = lane >> 4;
    constexpr int NKK = DK / 32;
    const size_t tok = (size_t)b * T_ + c * 64 + 16 * w + fr;
    const float qscale = HG ? 1.f : 0.17677669529663687f;
    const int trow = 16 * w + fr;
    u32x4 qrv[NKK];
#pragma unroll
    for (int kk = 0; kk < NKK; ++kk) qrv[kk] = *(const u32x4*)(proj + tok * NP + (HG ? C_HQ : C_CQ) + h * DK + 32 * kk + 8 * fq);
    rec_prologue<DK, HG>(p, layer, b, h, c, smem);
    const float* cumS = (const float*)smem; const float* keyS = (const float*)(smem + 17408); const bf16_t* vT = (const bf16_t*)(smem + 34816);
    {
        bf16_t* khT = (bf16_t*)(smem + 44032);
        constexpr int NG = 256 / DK, TPG = 64 / NG;
        {
            const int k = tid % DK, grp = tid / DK; const float last = cumS[63 * (DK + 1) + k];
#pragma unroll 4
            for (int i = 0; i < TPG; ++i) { const int s2 = grp * TPG + i; khT[k * LROW + s2] = f2bf(keyS[s2 * (DK + 1) + k] * exn(last - cumS[s2 * (DK + 1) + k])); }
        }
        __syncthreads();
        f32x4 accS[DK / 16];
#pragma unroll
        for (int n = 0; n < DK / 16; ++n) accS[n] = (f32x4){0.f, 0.f, 0.f, 0.f};
#pragma unroll
        for (int ks = 0; ks < 2; ++ks) {
            const bf16x8 a = *(const bf16x8*)(vT + (16 * w + fr) * LROW + 32 * ks + 8 * fq);
#pragma unroll
            for (int n = 0; n < DK / 16; ++n) { const bf16x8 bb = *(const bf16x8*)(khT + (16 * n + fr) * LROW + 32 * ks + 8 * fq); accS[n] = __builtin_amdgcn_mfma_f32_16x16x32_bf16(a, bb, accS[n], 0, 0, 0); }
        }
        float* sloc = (float*)(p.ws + (HG ? OFF_SLOC_H : OFF_SLOC_G)) + (size_t)(bh * 128 + c) * 64 * DK;
#pragma unroll
        for (int n = 0; n < DK / 16; ++n)
#pragma unroll
            for (int r = 0; r < 4; ++r) sloc[(16 * w + 4 * fq + r) * DK + 16 * n + fr] = accS[n][r];
        float* dec = (float*)(p.ws + (HG ? OFF_DEC_H : OFF_DEC_G)) + (size_t)(bh * 128 + c) * DK;
        if (tid < DK) dec[tid] = exn(cumS[63 * (DK + 1) + tid]);
    }
    bf16x8 Qt[NKK], Qh[NKK];
    float ref[NKK][8];
#pragma unroll
    for (int kk = 0; kk < NKK; ++kk) {
        const u32x4 qr = qrv[kk];
        const unsigned qq[4] = {qr.x, qr.y, qr.z, qr.w};
        union { bf16x8 v; unsigned u[4]; } ut, uh;
#pragma unroll
        for (int e2 = 0; e2 < 4; ++e2) {
            const int k0 = 32 * kk + 8 * fq + 2 * e2;
            const float r0 = w ? cumS[(16 * w - 1) * (DK + 1) + k0] : 0.f, r1 = w ? cumS[(16 * w - 1) * (DK + 1) + k0 + 1] : 0.f;
            ref[kk][2 * e2] = r0; ref[kk][2 * e2 + 1] = r1;
            const float c0 = cumS[trow * (DK + 1) + k0], c1 = cumS[trow * (DK + 1) + k0 + 1];
            const float q0 = bflo(qq[e2]) * qscale, q1 = bfhi(qq[e2]) * qscale;
            ut.u[e2] = pk_bf16(q0 * exn(c0 - r0), q1 * exn(c1 - r1));
            uh.u[e2] = pk_bf16(q0 * exn(c0), q1 * exn(c1));
        }
        Qt[kk] = ut.v; Qh[kk] = uh.v;
    }
    f32x4 sT[4];
#pragma unroll
    for (int j = 0; j < 4; ++j) {
        sT[j] = (f32x4){0.f, 0.f, 0.f, 0.f};
        if (j <= w) {
            const int srow = 16 * j + fr;
#pragma unroll
            for (int kk = 0; kk < NKK; ++kk) {
                union { bf16x8 v; unsigned u[4]; } kt;
#pragma unroll
                for (int e2 = 0; e2 < 4; ++e2) {
                    const int k0 = 32 * kk + 8 * fq + 2 * e2;
                    const float a0 = keyS[srow * (DK + 1) + k0] * exn(fminf(ref[kk][2 * e2] - cumS[srow * (DK + 1) + k0], 80.f));
                    const float a1 = keyS[srow * (DK + 1) + k0 + 1] * exn(fminf(ref[kk][2 * e2 + 1] - cumS[srow * (DK + 1) + k0 + 1], 80.f));
                    kt.u[e2] = pk_bf16(a0, a1);
                }
                sT[j] = __builtin_amdgcn_mfma_f32_16x16x32_bf16(kt.v, Qt[kk], sT[j], 0, 0, 0);
            }
            if (j == w) {
#pragma unroll
                for (int r = 0; r < 4; ++r) if (4 * fq + r > fr) sT[j][r] = 0.f;
            }
        }
    }
    f32x4 o[4];
#pragma unroll
    for (int vt = 0; vt < 4; ++vt) o[vt] = (f32x4){0.f, 0.f, 0.f, 0.f};
#pragma unroll
    for (int pr = 0; pr < 2; ++pr) {
        if (2 * pr <= w) {
            union { bf16x8 v; unsigned u[4]; } pf;
            pf.u[0] = pk_bf16(sT[2 * pr][0], sT[2 * pr][1]); pf.u[1] = pk_bf16(sT[2 * pr][2], sT[2 * pr][3]);
            pf.u[2] = pk_bf16(sT[2 * pr + 1][0], sT[2 * pr + 1][1]); pf.u[3] = pk_bf16(sT[2 * pr + 1][2], sT[2 * pr + 1][3]);
#pragma unroll
            for (int vt = 0; vt < 4; ++vt) {
                const bf16_t* vp = vT + (16 * vt + fr) * LROW + 32 * pr + 4 * fq;
                const u32x2 x0 = *(const u32x2*)vp, x1 = *(const u32x2*)(vp + 16);
                union { bf16x8 v; unsigned u[4]; } af; af.u[0] = x0.x; af.u[1] = x0.y; af.u[2] = x1.x; af.u[3] = x1.y;
                o[vt] = __builtin_amdgcn_mfma_f32_16x16x32_bf16(af.v, pf.v, o[vt], 0, 0, 0);
            }
        }
    }
    {
        bf16_t* OI = (bf16_t*)(p.ws + OFF_OI) + tok * 512 + (HG ? 0 : 256) + h * 64;
#pragma unroll
        for (int vt = 0; vt < 4; ++vt) { u32x2 ov; ov.x = pk_bf16(o[vt][0], o[vt][1]); ov.y = pk_bf16(o[vt][2], o[vt][3]); *(u32x2*)(OI + 16 * vt + 4 * fq) = ov; }
        bf16_t* QH = (bf16_t*)(p.ws + OFF_QH) + tok * 384 + (HG ? h * 64 : 256 + h * 32);
#pragma unroll
        for (int kk = 0; kk < NKK; ++kk) *(bf16x8*)(QH + 32 * kk + 8 * fq) = Qh[kk];
    }
}

template <int DK, bool HG>
__device__ __forceinline__ void rec_pass2(const Params& p, int layer, int witem) {
    const int lane = otid() & 63, fr = lane & 15, fq = lane >> 4;
    constexpr int NKK = DK / 32;
    const int tg = witem & 511, bh = witem >> 9, b = bh >> 2, h = bh & 3, c = tg >> 2;
    const size_t tok = (size_t)b * T_ + tg * 16 + fr;
    const bf16_t* proj = (const bf16_t*)(p.ws + OFF_PROJ);
    const float* gain = (HG ? p.hg : p.gg) + layer * 256 + h * 64;
    const bf16_t* sst = (const bf16_t*)(p.ws + (HG ? OFF_SST_H : OFF_SST_G)) + (size_t)(bh * 128 + c) * 64 * DK;
    const bf16_t* OI = (const bf16_t*)(p.ws + OFF_OI) + tok * 512 + (HG ? 0 : 256) + h * 64;
    const bf16_t* QH = (const bf16_t*)(p.ws + OFF_QH) + tok * 384 + (HG ? h * 64 : 256 + h * 32);
    bf16x8 Qh[NKK], sstv[4][NKK]; u32x2 gvv[4], oiv[4]; f32x4 gnv[4];
#pragma unroll
    for (int kk = 0; kk < NKK; ++kk) Qh[kk] = *(const bf16x8*)(QH + 32 * kk + 8 * fq);
#pragma unroll
    for (int vt = 0; vt < 4; ++vt) {
        oiv[vt] = *(const u32x2*)(OI + 16 * vt + 4 * fq);
        gvv[vt] = *(const u32x2*)(proj + tok * NP + (HG ? C_HG : C_CG) + h * 64 + 16 * vt + 4 * fq);
        gnv[vt] = *(const f32x4*)(gain + 16 * vt + 4 * fq);
#pragma unroll
        for (int kk = 0; kk < NKK; ++kk) sstv[vt][kk] = *(const bf16x8*)(sst + (16 * vt + fr) * DK + 32 * kk + 8 * fq);
    }
    f32x4 o[4];
#pragma unroll
    for (int vt = 0; vt < 4; ++vt) {
        o[vt] = (f32x4){bflo(oiv[vt].x), bfhi(oiv[vt].x), bflo(oiv[vt].y), bfhi(oiv[vt].y)};
#pragma unroll
        for (int kk = 0; kk < NKK; ++kk) o[vt] = __builtin_amdgcn_mfma_f32_16x16x32_bf16(sstv[vt][kk], Qh[kk], o[vt], 0, 0, 0);
    }
    float ss = 0.f;
#pragma unroll
    for (int vt = 0; vt < 4; ++vt)
#pragma unroll
        for (int r = 0; r < 4; ++r) ss += o[vt][r] * o[vt][r];
    ss += __shfl_xor(ss, 16); ss += __shfl_xor(ss, 32);
    const float rinv = rsqrtf(ss * (1.f / 64.f) + EPS);
    bf16_t* Y = (bf16_t*)(p.ws + OFF_Y);
#pragma unroll
    for (int vt = 0; vt < 4; ++vt) {
        const int v = 16 * vt + 4 * fq;
        const u32x2 gv = gvv[vt];
        const f32x4 gn = gnv[vt];
        u32x2 ov;
        ov.x = pk_bf16(o[vt][0] * rinv * gn[0] * siluf(bflo(gv.x)), o[vt][1] * rinv * gn[1] * siluf(bfhi(gv.x)));
        ov.y = pk_bf16(o[vt][2] * rinv * gn[2] * siluf(bflo(gv.y)), o[vt][3] * rinv * gn[3] * siluf(bfhi(gv.y)));
        *(u32x2*)(Y + tok * 768 + (HG ? 256 : 512) + h * 64 + v) = ov;
    }
}

__device__ __forceinline__ void phase_gates(const Params& p, int layer, char* smem) {
    pg8::Gemm g; g.A = (const bf16_t*)(p.ws + OFF_XB); g.Bt = (const bf16_t*)(p.ws + OFF_WT_IN + layer * SZ_WT_IN) + (size_t)NWG * 1024; g.M = M_; g.N = 3072; g.K = 1024;
    pg8::StaticOrder S; S.init(M_, 3072, onb(), obid());
    pg8::EpiBf16S<2> E; E.O = (bf16_t*)(p.ws + OFF_GATES); E.ldc = 3072; E.split_cols = 0; E.split_stride = 0;
    __syncthreads();
    pg8::gemm_phase<pg8::EpiBf16S<2>, pg8::StaticOrder, true, true>((PG8_LAS unsigned char*)smem, g, S, E);
}

struct UpOrder {
    int pm, j, ok;
    __device__ __forceinline__ bool next(int i, pg8::Unit& u) const { if (!ok || i >= 3) return false; u.pm = pm; u.pn = j + 4 * i; return true; }
    __device__ __forceinline__ void a_ready(const pg8::Unit&) const {}
    __device__ __forceinline__ void done(const pg8::Unit&) const {}
    __device__ __forceinline__ size_t a_off(const pg8::Unit& u) const { return (size_t)(u.pn >> 2) * 256 * 2; }
};
struct EpiUp {
    static constexpr bool PERM = true, AFTER_DRAIN = false, KEEP_ACC = true;
    bf16_t* gates; bf16_t* mg;
    __device__ __forceinline__ void operator()(f32x4 (&acc)[2][2][4][2], const pg8::Unit& u, int wr, int wc, int fr, int fq) const {
        const int n = u.pn >> 2, j = u.pn & 3;
        const int col = j * 256 + wc * 32 + 8 * fq;
        const bf16_t* gbase = gates + (size_t)(u.pm * 256 + wr * 64 + fr) * 3072 + n * 1024 + col;
        bf16_t* mbase = mg + (size_t)(u.pm * 256 + wr * 64 + fr) * 1024 + col;
        const float GMIN = 8.6736174e-19f;
        u32x4 Gq[8][2], Nq[8][2];
#define UP_LOAD(gi_) do { const size_t ro_ = (size_t)(((gi_) >> 2) * 128 + ((gi_) & 3) * 16) * 3072; \
            _Pragma("unroll") for (int bj = 0; bj < 2; ++bj) { Gq[gi_][bj] = *(const u32x4*)(gbase + ro_ + bj * 128); Nq[gi_][bj] = n < 2 ? *(const u32x4*)(gbase + ro_ + 1024 + bj * 128) : (u32x4){0u, 0u, 0u, 0u}; } } while (0)
        UP_LOAD(0); UP_LOAD(1);
#pragma unroll
        for (int gi = 0; gi < 8; ++gi) {
            const int ai = gi >> 2, m = gi & 3;
            if (gi + 2 < 8) UP_LOAD(gi + 2);
            __builtin_amdgcn_sched_barrier(0);
#pragma unroll
            for (int bj = 0; bj < 2; ++bj) {
                const u32x4 g = Gq[gi][bj], q = Nq[gi][bj];
                const unsigned gw[4] = {g.x, g.y, g.z, g.w}, qw[4] = {q.x, q.y, q.z, q.w};
                float r[8];
#pragma unroll
                for (int e = 0; e < 4; ++e) {
                    const float a0 = (e < 2 ? acc[ai][bj][m][0][2 * e] : acc[ai][bj][m][1][2 * e - 4]), a1 = (e < 2 ? acc[ai][bj][m][0][2 * e + 1] : acc[ai][bj][m][1][2 * e - 3]);
                    r[2 * e] = a0 * fmaxf(bflo(gw[e]), GMIN); r[2 * e + 1] = a1 * fmaxf(bfhi(gw[e]), GMIN);
                }
                if (n < 2) {
#pragma unroll
                    for (int e = 0; e < 4; ++e) { r[2 * e] *= __builtin_amdgcn_rcpf(fmaxf(bflo(qw[e]), GMIN)); r[2 * e + 1] *= __builtin_amdgcn_rcpf(fmaxf(bfhi(qw[e]), GMIN)); }
                    acc[ai][bj][m][0] = (f32x4){r[0], r[1], r[2], r[3]}; acc[ai][bj][m][1] = (f32x4){r[4], r[5], r[6], r[7]};
                } else {
                    u32x4 w4; w4.x = pk_bf16(r[0], r[1]); w4.y = pk_bf16(r[2], r[3]); w4.z = pk_bf16(r[4], r[5]); w4.w = pk_bf16(r[6], r[7]);
                    *(u32x4*)(mbase + (size_t)(ai * 128 + m * 16) * 1024 + bj * 128) = w4;
                }
            }
            __builtin_amdgcn_sched_barrier(0);
        }
#undef UP_LOAD
    }
};
__device__ __forceinline__ void phase_upmerge(const Params& p, int layer, char* smem) {
    pg8::Gemm g; g.A = (const bf16_t*)(p.ws + OFF_Y); g.Bt = (const bf16_t*)(p.ws + OFF_WT_UP + layer * SZ_WT_UP); g.M = M_; g.N = 3072; g.K = 256; g.lda = 768;
    UpOrder S; S.ok = tile_order(obid(), 64, 4, S.pm, S.j) ? 1 : 0;
    EpiUp E; E.gates = (bf16_t*)(p.ws + OFF_GATES); E.mg = (bf16_t*)(p.ws + OFF_MERGED);
    __syncthreads();
    pg8::gemm_phase<EpiUp, UpOrder, true, true>((PG8_LAS unsigned char*)smem, g, S, E);
}

struct EpiOutLn {
    static constexpr bool PERM = false, AFTER_DRAIN = true, KEEP_ACC = false;
    const float* resid; float* out; bf16_t* xb; const float* lg; const float* lb; unsigned long long* stats; unsigned* cnt; int write_xb;
    __device__ __forceinline__ void fused(f32x4 (&acc)[2][2][4][2], const pg8::Unit& u, int wr, int wc, int fr, int fq, PG8_LAS unsigned char* lds, int wid, int lane) const {
        PG8_LAS float* P = (PG8_LAS float*)lds;
        PG8_LAS float* S = (PG8_LAS float*)(lds + 8192);
        const int tid = wid * 64 + lane, tm = u.pm, tn = u.pn;
        const int col0 = tn * 256 + wc * 32 + 4 * fq;
        f32x4 lgv[2][2], lbv[2][2];
#pragma unroll
        for (int bj = 0; bj < 2; ++bj)
#pragma unroll
            for (int n = 0; n < 2; ++n) { lgv[bj][n] = *(const f32x4*)(lg + col0 + bj * 128 + n * 16); lbv[bj][n] = *(const f32x4*)(lb + col0 + bj * 128 + n * 16); }
#pragma unroll
        for (int ai = 0; ai < 2; ++ai)
#pragma unroll
            for (int m = 0; m < 4; ++m) {
                const int rl = ai * 128 + wr * 64 + m * 16 + fr; const size_t rowoff = (size_t)(tm * 256 + rl) * 1024 + col0;
                float s1 = 0.f, s2 = 0.f;
#pragma unroll
                for (int bj = 0; bj < 2; ++bj)
#pragma unroll
                    for (int n = 0; n < 2; ++n) { const f32x4 rv = *(const f32x4*)(resid + rowoff + bj * 128 + n * 16); const f32x4 x = rv * ALPHA + acc[ai][bj][m][n]; acc[ai][bj][m][n] = x;
                        s1 += (x[0] + x[1]) + (x[2] + x[3]); s2 += (x[0] * x[0] + x[1] * x[1]) + (x[2] * x[2] + x[3] * x[3]); }
                s1 += __shfl_xor(s1, 16); s1 += __shfl_xor(s1, 32); s2 += __shfl_xor(s2, 16); s2 += __shfl_xor(s2, 32);
                if (fq == 0) { P[(rl * 4 + wc) * 2] = s1; P[(rl * 4 + wc) * 2 + 1] = s2; }
            }
        __syncthreads();
        if (tid < 256) {
            const float a = (P[(tid * 4 + 0) * 2] + P[(tid * 4 + 1) * 2]) + (P[(tid * 4 + 2) * 2] + P[(tid * 4 + 3) * 2]);
            const float b = (P[(tid * 4 + 0) * 2 + 1] + P[(tid * 4 + 1) * 2 + 1]) + (P[(tid * 4 + 2) * 2 + 1] + P[(tid * 4 + 3) * 2 + 1]);
            __hip_atomic_store(stats + ((size_t)(tm * 4 + tn) * 256 + tid), ((unsigned long long)__float_as_uint(b) << 32) | __float_as_uint(a), __ATOMIC_RELAXED, __HIP_MEMORY_SCOPE_AGENT);
        }
        asm volatile("s_waitcnt vmcnt(0)" ::: "memory");
        __syncthreads();
        if (tid == 0) {
            __hip_atomic_fetch_add(cnt + tm, 1u, __ATOMIC_RELEASE, __HIP_MEMORY_SCOPE_AGENT);
            unsigned sp = 0;
            while (__hip_atomic_load(cnt + tm, __ATOMIC_RELAXED, __HIP_MEMORY_SCOPE_AGENT) < 4u) { __builtin_amdgcn_s_sleep(1); if (++sp > (1u << 22)) break; }
            __builtin_amdgcn_fence(__ATOMIC_ACQUIRE, "agent");
            asm volatile("s_waitcnt vmcnt(0)" ::: "memory");
        }
        __syncthreads();
        if (tid < 256) {
            float a = 0.f, b = 0.f;
#pragma unroll
            for (int t = 0; t < 4; ++t) { const unsigned long long pk = __hip_atomic_load(stats + ((size_t)(tm * 4 + t) * 256 + tid), __ATOMIC_RELAXED, __HIP_MEMORY_SCOPE_AGENT);
                a += __uint_as_float((unsigned)pk); b += __uint_as_float((unsigned)(pk >> 32)); }
            const float mean = a * (1.f / 1024.f), var = fmaxf(b * (1.f / 1024.f) - mean * mean, 0.f);
            S[tid * 2] = mean; S[tid * 2 + 1] = rsqrtf(var + EPS);
        }
        __syncthreads();
#pragma unroll
        for (int ai = 0; ai < 2; ++ai)
#pragma unroll
            for (int m = 0; m < 4; ++m) {
                const int rl = ai * 128 + wr * 64 + m * 16 + fr; const float mean = S[rl * 2], rstd = S[rl * 2 + 1];
                const size_t rowoff = (size_t)(tm * 256 + rl) * 1024 + col0;
#pragma unroll
                for (int bj = 0; bj < 2; ++bj)
#pragma unroll
                    for (int n = 0; n < 2; ++n) {
                        const f32x4 gv = lgv[bj][n], bv = lbv[bj][n];
                        const f32x4 y = (acc[ai][bj][m][n] - mean) * rstd * gv + bv;
                        *(f32x4*)(out + rowoff + bj * 128 + n * 16) = y;
                        if (write_xb) { u32x2 o; o.x = pk_bf16(y[0], y[1]); o.y = pk_bf16(y[2], y[3]); *(u32x2*)(xb + rowoff + bj * 128 + n * 16) = o; }
                    }
            }
    }
};
__device__ __forceinline__ void phase_outproj_ln(const Params& p, int layer, char* smem) {
    pg8::Gemm g; g.A = (const bf16_t*)(p.ws + OFF_MERGED); g.Bt = (const bf16_t*)(p.ws + OFF_WT_OUT + layer * SZ_WT_OUT); g.M = M_; g.N = 1024; g.K = 1024;
    pg8::StaticOrder S; S.init(M_, 1024, onb(), obid());
    EpiOutLn E; E.resid = layer == 0 ? p.x : p.out; E.out = p.out; E.xb = (bf16_t*)(p.ws + OFF_XB); E.lg = p.ln_g + layer * 1024; E.lb = p.ln_b + layer * 1024;
    E.stats = (unsigned long long*)(p.ws + OFF_STATS) + (size_t)layer * 64 * 4 * 256; E.cnt = (unsigned*)(p.ws + OFF_BAR) + layer * 64; E.write_xb = layer == 0;
    __syncthreads();
    pg8::gemm_phase<EpiOutLn, pg8::StaticOrder, false, true>((PG8_LAS unsigned char*)smem, g, S, E);
}

#define XB_TMO      128
#define XB_XCNT(j)  (256  + 64 * (j))
#define XB_XSUB(j)  (1280 + 64 * (j))
#define XB_XGEN(j)  (2304 + 64 * (j))
#define XB_TOP      3328
#define XB_TOPGEN   3392
#define XCD_BAR_WORDS 3456
#define XB_SPIN_CAP (1u << 18)
__device__ __forceinline__ unsigned xb_ld(unsigned* p)              { return __hip_atomic_load(p, __ATOMIC_RELAXED, __HIP_MEMORY_SCOPE_AGENT); }
__device__ __forceinline__ unsigned xb_add(unsigned* p, unsigned v) { return __hip_atomic_fetch_add(p, v, __ATOMIC_RELAXED, __HIP_MEMORY_SCOPE_AGENT); }
__device__ __forceinline__ unsigned xb_xcc_id() { return (unsigned)__builtin_amdgcn_s_getreg((3 << 11) | 20) & 0xFu; }
#define XB_SPIN(cond, bar) do { unsigned _sp = 0; while (cond) { __builtin_amdgcn_s_sleep(1); \
    if ((++_sp & 255u) == 0u) { if (xb_ld(&(bar)[XB_TMO])) break; if (_sp > XB_SPIN_CAP) { atomicAdd(&(bar)[XB_TMO], 1u); break; } } } } while (0)
struct XcdBarrier { unsigned* bar; unsigned x; volatile LDSP unsigned* st; };
__device__ __forceinline__ XcdBarrier xcd_barrier_post(unsigned* bar, volatile LDSP unsigned* st) {
    XcdBarrier b; b.bar = bar; b.x = xb_xcc_id(); b.st = st;
    if (threadIdx.x == 0) (void)xb_add(&bar[XB_XCNT(b.x)], 1u);
    return b;
}
__device__ __forceinline__ void xcd_barrier_complete(unsigned* bar, unsigned x, unsigned& nloc, unsigned& nx) {
    const unsigned G = gridDim.x * gridDim.y * gridDim.z;
    unsigned sum, cnt, mine, sp = 0u;
    for (;;) {
        sum = 0u; cnt = 0u; mine = 0u;
#pragma unroll
        for (unsigned j = 0; j < 16; ++j) { const unsigned c = xb_ld(&bar[XB_XCNT(j)]); sum += c; cnt += (c > 0u) ? 1u : 0u; mine = (j == x) ? c : mine; }
        if (sum == G) break;
        __builtin_amdgcn_s_sleep(1);
        if ((++sp & 255u) == 0u) { if (xb_ld(&bar[XB_TMO])) break; if (sp > XB_SPIN_CAP) { atomicAdd(&bar[XB_TMO], 1u); break; } }
    }
    nloc = mine > 0u ? mine : 1u; nx = cnt > 0u ? cnt : 1u;
}
__device__ __forceinline__ void xcd_barrier(const XcdBarrier& b) {
    asm volatile("s_waitcnt vmcnt(0)" ::: "memory");
    __syncthreads();
    if (threadIdx.x == 0) {
        unsigned* bar = b.bar;
        __builtin_amdgcn_s_waitcnt(0);
        unsigned nloc = b.st[0], nx = b.st[1];
        if (nloc == 0u) { xcd_barrier_complete(bar, b.x, nloc, nx); b.st[0] = nloc; b.st[1] = nx; }
        const unsigned old = xb_add(&bar[XB_XSUB(b.x)], 1u);
        const unsigned gen = old / nloc;
        if (old + 1u == (gen + 1u) * nloc) {
            __builtin_amdgcn_fence(__ATOMIC_RELEASE, "agent");
            asm volatile("s_waitcnt vmcnt(0)" ::: "memory");
            const unsigned og = xb_add(&bar[XB_TOP], 1u);
            const unsigned tg = og / nx;
            if (og + 1u == (tg + 1u) * nx) xb_add(&bar[XB_TOPGEN], 1u);
            else XB_SPIN(xb_ld(&bar[XB_TOPGEN]) == tg, bar);
            __builtin_amdgcn_fence(__ATOMIC_ACQUIRE, "agent");
            xb_add(&bar[XB_XGEN(b.x)], 1u);
            asm volatile("s_waitcnt vmcnt(0)" ::: "memory");
        } else {
            XB_SPIN(xb_ld(&bar[XB_XGEN(b.x)]) == gen, bar);
            __builtin_amdgcn_fence(__ATOMIC_ACQUIRE, "agent");
            asm volatile("s_waitcnt vmcnt(0)" ::: "memory");
        }
    }
    __syncthreads();
}

__global__ void __launch_bounds__(512, 2) hybrid_fwd(Params p, int ph_lo, int ph_hi) {
    __shared__ __attribute__((aligned(1024))) char smem[SMEM_BYTES];
    __shared__ uint4 xb_words;
    cg::grid_group grid = cg::this_grid();
    if (ph_lo < 0) grid.sync();
    if (threadIdx.x == 0) xb_words = make_uint4(0u, 0u, 0u, 0u);
    __syncthreads();
    const XcdBarrier xb = xcd_barrier_post((unsigned*)(p.ws + OFF_BAR), (volatile LDSP unsigned*)&xb_words);
    for (int ph = ph_lo; ph <= ph_hi; ++ph) {
        const int nb = onb(), bid = obid();
        if (ph == 0) phase_prepass(p, smem);
        else {
            const int layer = (ph - 1) / 7, s = (ph - 1) % 7;
            if (s == 0) phase_inproj(p, layer, smem);
            else if (s == 1) {
                for (int it = bid; it < 256 + 1024; it += nb) {
                    if (it < 256) attn_item(p, it * 8 + (otid() >> 6));
                    else if (it < 256 + 512) rec_pass1<64, true>(p, layer, it - 256, smem);
                    else rec_pass1<32, false>(p, layer, it - 768, smem);
                }
            } else if (s == 2) { for (int it = bid; it < 192; it += nb) rec_stepB(p, it); }
            else if (s == 3) {
                for (int wi = bid * 8 + (otid() >> 6); wi < 8192; wi += nb * 8) {
                    if (wi < 4096) rec_pass2<64, true>(p, layer, wi);
                    else rec_pass2<32, false>(p, layer, wi - 4096);
                }
            } else if (s == 4) phase_gates(p, layer, smem);
            else if (s == 5) phase_upmerge(p, layer, smem);
            else phase_outproj_ln(p, layer, smem);
        }
        if (ph < ph_hi) xcd_barrier(xb);
    }
}

extern "C" void kernel_launch(void* const* d_in, const int* in_sizes, int n_in, void* d_out, int out_size, void* d_ws, size_t ws_size, hipStream_t stream) {
    (void)in_sizes; (void)n_in; (void)out_size;
    if (ws_size < WS_NEED) { fprintf(stderr, "workspace too small: %zu < %zu\n", ws_size, (size_t)WS_NEED); return; }
    static int grid_blocks = 0;
    if (!grid_blocks) {
        int dev = 0, cus = 0, per_cu = 0;
        (void)hipGetDevice(&dev);
        (void)hipDeviceGetAttribute(&cus, hipDeviceAttributeMultiprocessorCount, dev);
        (void)hipOccupancyMaxActiveBlocksPerMultiprocessor(&per_cu, hybrid_fwd, NTH, 0);
        if (per_cu > 1) per_cu = 1;
        if (per_cu < 1) per_cu = 1;
        grid_blocks = cus * per_cu;
        grid_blocks -= grid_blocks % 8;
    }
    Params p{};
    p.x = (const float*)d_in[0]; p.w_in = (const float*)d_in[1]; p.w2 = (const float*)d_in[2]; p.gb = (const float*)d_in[3];
    p.lbl = (const float*)d_in[4]; p.hg = (const float*)d_in[5]; p.gg = (const float*)d_in[6]; p.w_up = (const float*)d_in[7];
    p.w_out = (const float*)d_in[8]; p.ln_g = (const float*)d_in[9]; p.ln_b = (const float*)d_in[10];
    p.out = (float*)d_out; p.ws = (char*)d_ws;
    int lo = 0, hi = 14;
    void* args[] = {&p, &lo, &hi};
    (void)hipMemsetAsync((char*)d_ws + OFF_BAR, 0, XCD_BAR_WORDS * 4, stream);
    hipError_t e = hipLaunchCooperativeKernel((void*)hybrid_fwd, dim3(grid_blocks), dim3(NTH), args, 0, stream);
    if (e != hipSuccess) fprintf(stderr, "cooperative launch failed: %s (grid %d)\n", hipGetErrorString(e), grid_blocks);
}
```
